# Optimizing an MI355X kernel written in HIP

```python
import math
import jax, jax.numpy as jnp
from jax import lax
import numpy as np

D_MODEL = 1024
BATCH = 2
SEQ = 8192
DEPTH = 4
DEC_BATCH = 128
DEC_SEQ = 4
PAST_LEN = 8192
PAGE_SIZE = 128

N_A = DEPTH // 2
N_B = DEPTH - N_A
POOL_WINDOWS = (2, 4, 8, 16)
N_POOL_GROUPS = len(POOL_WINDOWS)
POOL_GROUP = D_MODEL // N_POOL_GROUPS
POOL_BUF = max(POOL_WINDOWS) - 1
HEAD_DIM = 64
N_HEADS = D_MODEL // HEAD_DIM
N_KV = 4
GROUP = N_HEADS // N_KV
WINDOW = 128
BLOCK = WINDOW
N_BUCKETS = 32
MAX_DISTANCE = 128
D_FF = 2816
CONV_W = 3
CONV_BUF = CONV_W - 1
PLE_DIM = 256
EPS = 1e-6

kernel_name = 'yoco_pool_swa_sink_convffn_step'


def rmsnorm(x, g):
    xf = x.astype(jnp.float32)
    y = xf * lax.rsqrt(jnp.mean(xf * xf, axis=-1, keepdims=True) + EPS)
    return (y * g.astype(jnp.float32)).astype(x.dtype)


def pool_mixer(xn, prefix, start, w_grp, scale):
    N, L, _ = xn.shape
    ext = jnp.concatenate([prefix.astype(xn.dtype), xn], axis=1).astype(jnp.float32)
    c = jnp.pad(jnp.cumsum(ext, axis=1), ((0, 0), (1, 0), (0, 0)))
    pos = start + jnp.arange(L)
    outs = []
    for g, w in enumerate(POOL_WINDOWS):
        sl = slice(g * POOL_GROUP, (g + 1) * POOL_GROUP)
        cg = c[:, :, sl]
        s = cg[:, POOL_BUF + 1:] - cg[:, POOL_BUF + 1 - w:POOL_BUF + 1 - w + L]
        cnt = jnp.minimum(pos + 1, w).astype(jnp.float32)
        outs.append(s / cnt[None, :, None] - ext[:, POOL_BUF:, sl])
    d = jnp.stack(outs, axis=2).astype(xn.dtype)
    y = jnp.einsum('nlgc,gcd->nlgd', d, w_grp).reshape(N, L, D_MODEL)
    return y * scale


def conv_ffn(xn, prefix, w_up, conv_w, conv_b, w_down):
    L = xn.shape[1]
    u = xn @ w_up
    ext = jnp.concatenate([prefix.astype(u.dtype), u], axis=1)
    c = conv_b + ext[:, 0:L] * conv_w[0]
    for k in range(1, CONV_W):
        c = c + ext[:, k:k + L] * conv_w[k]
    gate, val = jnp.split(c, 2, axis=-1)
    return (jax.nn.gelu(gate) * val) @ w_down, ext[:, -CONV_BUF:]


def t5_bucket(d):
    n = jnp.maximum(d, 0)
    max_exact = N_BUCKETS // 2
    nf = jnp.maximum(n, 1).astype(jnp.float32)
    large = max_exact + (jnp.log(nf / max_exact) / math.log(MAX_DISTANCE / max_exact)
                         * (N_BUCKETS - max_exact)).astype(jnp.int32)
    large = jnp.minimum(large, N_BUCKETS - 1)
    return jnp.where(n < max_exact, n, large)


def window_attention(q, k, v, bias, valid, sink):
    s = jnp.einsum('nbqhgd,nbjhd->nbhgqj', q, k).astype(jnp.float32) * (HEAD_DIM ** -0.5)
    s = jnp.where(valid[None, :, None, None], s + bias, -jnp.inf)
    sk = sink.astype(jnp.float32)[None, None, :, :, None, None]
    m = jnp.maximum(jnp.max(s, axis=-1, keepdims=True), sk)
    e = jnp.exp(s - m)
    p = e / (jnp.sum(e, axis=-1, keepdims=True) + jnp.exp(sk - m))
    return jnp.einsum('nbhgqj,nbjhd->nbqhgd', p.astype(v.dtype), v)


def shared_kv(h, kv_norm, w_k, w_v, k_norm):
    N, L, _ = h.shape
    xn = rmsnorm(h, kv_norm)
    k = rmsnorm((xn @ w_k).reshape(N, L, N_KV, HEAD_DIM), k_norm)
    v = (xn @ w_v).reshape(N, L, N_KV, HEAD_DIM)
    return k, v


def trunk(x, p, pool_prev, conv_prev, k_prev, v_prev, start, prompt, W):
    N, L, _ = x.shape
    h = x
    pool_new, conv_new = [], []
    nblk, qlen = (L // BLOCK, BLOCK) if prompt else (1, L)
    for i in range(DEPTH):
        if i == N_A:
            k_new, v_new = shared_kv(h, W['kv_norm'], W['w_k'], W['w_v'], W['k_norm'])
            if prompt:
                kb = k_new.reshape(N, nblk, BLOCK, N_KV, HEAD_DIM)
                vb = v_new.reshape(N, nblk, BLOCK, N_KV, HEAD_DIM)
                padb = ((0, 0), (1, 0), (0, 0), (0, 0), (0, 0))
                k_blk = jnp.concatenate([jnp.pad(kb[:, :-1], padb), kb], axis=2)
                v_blk = jnp.concatenate([jnp.pad(vb[:, :-1], padb), vb], axis=2)
                k_win, v_win = k_new[:, -WINDOW:], v_new[:, -WINDOW:]
                kj = jnp.arange(2 * BLOCK)[None, :]
                d = jnp.arange(BLOCK)[:, None] + BLOCK - kj
                valid = ((d >= 0) & (d < WINDOW))[None] & (
                    (jnp.arange(nblk)[:, None, None] > 0) | (kj >= BLOCK)[None])
            else:
                k_ext = jnp.concatenate([k_prev.astype(k_new.dtype), k_new], axis=1)
                v_ext = jnp.concatenate([v_prev.astype(v_new.dtype), v_new], axis=1)
                k_win, v_win = k_ext[:, -WINDOW:], v_ext[:, -WINDOW:]
                k_blk, v_blk = k_ext[:, None], v_ext[:, None]
                d = jnp.arange(L)[:, None] + WINDOW - jnp.arange(WINDOW + L)[None, :]
                valid = ((d >= 0) & (d < WINDOW))[None]
            bias = jnp.transpose(W['rel_bias'][t5_bucket(d)], (2, 0, 1))
            bias = bias.reshape(N_KV, GROUP, qlen, -1).astype(jnp.float32)
        xn = rmsnorm(h, W['norm_mix'][i])
        if i < N_A:
            pre = jnp.zeros((N, POOL_BUF, D_MODEL), xn.dtype) if prompt else pool_prev[i].astype(xn.dtype)
            h = h + pool_mixer(xn, pre, start, W['w_pool'][i], W['pool_scale'][i])
            pool_new.append(jnp.concatenate([pre, xn], axis=1)[:, -POOL_BUF:])
        else:
            j = i - N_A
            q = (xn @ W['w_q'][j]).reshape(N, nblk, qlen, N_KV, GROUP, HEAD_DIM)
            q = rmsnorm(q, W['q_norm'][j])
            o = window_attention(q, k_blk, v_blk, bias, valid, W['sinks'][j].reshape(N_KV, GROUP))
            h = h + o.reshape(N, L, D_MODEL) @ W['w_o'][j]
        xn = rmsnorm(h, W['norm_ffn'][i])
        cpre = jnp.zeros((N, CONV_BUF, 2 * D_FF), xn.dtype) if prompt else conv_prev[i]
        f, cstate = conv_ffn(xn, cpre, W['w_up'][i], W['conv_w'][i], W['conv_b'][i], W['w_down'][i])
        h = h + f
        conv_new.append(cstate)
        gate = jax.nn.sigmoid(rmsnorm(h, W['norm_ple'][i]) @ W['w_ple_gate'][i])
        h = h + gate * (p[i] @ W['w_ple_proj'][i])
    return h, jnp.stack(pool_new), jnp.stack(conv_new), k_win, v_win


def setup_inputs(seed: int = 0) -> dict:
    key = jax.random.key(seed)
    ks = iter(jax.random.split(key, 40))

    def nrm(shape, scale):
        return jax.random.normal(next(ks), shape, jnp.float32) * scale

    F2 = 2 * D_FF
    return {
        'x_prompt': nrm((BATCH, SEQ, D_MODEL), 1.0),
        'x_sample': nrm((DEC_BATCH, DEC_SEQ, D_MODEL), 1.0),
        'p_prompt': nrm((DEPTH, BATCH, SEQ, PLE_DIM), 1.0),
        'p_sample': nrm((DEPTH, DEC_BATCH, DEC_SEQ, PLE_DIM), 1.0),
        'state_pool': nrm((N_A, DEC_BATCH, POOL_BUF, D_MODEL), 1.0),
        'state_conv': nrm((DEPTH, DEC_BATCH, CONV_BUF, F2), 1.0),
        'cache_k': nrm((DEC_BATCH, WINDOW, N_KV, HEAD_DIM), 1.0),
        'cache_v': nrm((DEC_BATCH, WINDOW, N_KV, HEAD_DIM), 1.0),
        'norm_mix': 1.0 + nrm((DEPTH, D_MODEL), 0.05),
        'norm_ffn': 1.0 + nrm((DEPTH, D_MODEL), 0.05),
        'norm_ple': 1.0 + nrm((DEPTH, D_MODEL), 0.05),
        'w_pool': nrm((N_A, N_POOL_GROUPS, POOL_GROUP, POOL_GROUP), POOL_GROUP ** -0.5),
        'pool_scale': 1.0 + nrm((N_A, D_MODEL), 0.1),
        'kv_norm': 1.0 + nrm((D_MODEL,), 0.05),
        'w_k': nrm((D_MODEL, N_KV * HEAD_DIM), D_MODEL ** -0.5),
        'w_v': nrm((D_MODEL, N_KV * HEAD_DIM), D_MODEL ** -0.5),
        'k_norm': 1.0 + nrm((HEAD_DIM,), 0.05),
        'w_q': nrm((N_B, D_MODEL, D_MODEL), D_MODEL ** -0.5),
        'q_norm': 1.0 + nrm((N_B, HEAD_DIM), 0.05),
        'sinks': nrm((N_B, N_HEADS), 0.5),
        'w_o': nrm((N_B, D_MODEL, D_MODEL), D_MODEL ** -0.5),
        'rel_bias': nrm((N_BUCKETS, N_HEADS), 0.5),
        'w_up': nrm((DEPTH, D_MODEL, F2), D_MODEL ** -0.5),
        'conv_w': nrm((DEPTH, CONV_W, F2), 0.5),
        'conv_b': nrm((DEPTH, F2), 0.02),
        'w_down': nrm((DEPTH, D_FF, D_MODEL), D_FF ** -0.5),
        'w_ple_gate': nrm((DEPTH, D_MODEL, D_MODEL), D_MODEL ** -0.5),
        'w_ple_proj': nrm((DEPTH, PLE_DIM, D_MODEL), PLE_DIM ** -0.5),
    }


def reference(x_prompt, x_sample, p_prompt, p_sample, state_pool, state_conv, cache_k, cache_v,
              norm_mix, norm_ffn, norm_ple, w_pool, pool_scale, kv_norm, w_k, w_v, k_norm,
              w_q, q_norm, sinks, w_o, rel_bias, w_up, conv_w, conv_b, w_down, w_ple_gate, w_ple_proj):
    W = dict(norm_mix=norm_mix, norm_ffn=norm_ffn, norm_ple=norm_ple, w_pool=w_pool,
             pool_scale=pool_scale, kv_norm=kv_norm, w_k=w_k, w_v=w_v, k_norm=k_norm,
             w_q=w_q, q_norm=q_norm, sinks=sinks, w_o=w_o, rel_bias=rel_bias, w_up=w_up,
             conv_w=conv_w, conv_b=conv_b, w_down=w_down, w_ple_gate=w_ple_gate,
             w_ple_proj=w_ple_proj)
    y_prompt, pool_p, conv_p, k_p, v_p = trunk(x_prompt, p_prompt, None, None, None, None,
                                               0, True, W)
    y_sample, pool_s, conv_s, k_s, v_s = trunk(x_sample, p_sample, state_pool, state_conv,
                                               cache_k, cache_v, PAST_LEN, False, W)
    return (y_prompt, y_sample, pool_p, pool_s, conv_p, conv_s, k_p, k_s, v_p, v_s)
```

```cpp
#include <hip/hip_runtime.h>
#include <cstdio>
#include <cstdint>

#ifndef MK_N_LAUNCHES
#define MK_N_LAUNCHES 1
#endif
#ifndef PROBE_REP_TYPE
#define PROBE_REP_TYPE -1
#endif
#ifndef PROBE_REPS
#define PROBE_REPS 0
#endif
#ifndef PROBE_DRY
#define PROBE_DRY 1
#endif

#define LAS __attribute__((address_space(3)))
#define GAS __attribute__((address_space(1)))
typedef unsigned short bf16_t;
typedef short bf16x8 __attribute__((ext_vector_type(8)));
typedef float f32x4 __attribute__((ext_vector_type(4)));
typedef float f32x2 __attribute__((ext_vector_type(2)));
typedef float f32x16 __attribute__((ext_vector_type(16)));
typedef unsigned u32x4 __attribute__((ext_vector_type(4)));
typedef unsigned u32x2 __attribute__((ext_vector_type(2)));
typedef __bf16 bf16x2_t __attribute__((ext_vector_type(2)));

constexpr int T = 16896, TP = 16384, D = 1024, FF = 2816, F2 = 5632, PLE = 256, SEQ = 8192, NSEQ = 128;
constexpr float EPS = 1e-6f;
constexpr float LOG2E = 1.4426950408889634f;
constexpr float QSCALE = 0.125f * LOG2E;
enum { I_XP = 0, I_XS, I_PP, I_PS, I_SPOOL, I_SCONV, I_CK, I_CV, I_NMIX, I_NFFN, I_NPLE, I_WPOOL, I_PSCALE, I_KVN, I_WK, I_WV, I_KN, I_WQ, I_QN, I_SINK, I_WO, I_RELB, I_WUP, I_CONVW, I_CONVB, I_WDN, I_WG, I_WPJ, N_IN };
constexpr size_t OFF_Y = 0, OFF_SPP = 17301504, OFF_SPS = 17362944, OFF_SCP = 21295104, OFF_SCS = 21385216, OFF_KP = 27152384, OFF_KS = 27217920, OFF_VP = 31412224, OFF_VS = 31477760, OUT_TOTAL = 35672064;
constexpr size_t MiB = 1u << 20;
constexpr size_t WS_CTL = 0, CTL_ZERO_BYTES = 32768;
constexpr size_t WS_BTAB = 1 * MiB;
constexpr size_t WS_WUP = 2 * MiB, WS_WDN = 46 * MiB, WS_WG = 68 * MiB, WS_WP = 76 * MiB, WS_WQK = 78 * MiB, WS_WV = 83 * MiB, WS_WO = 84 * MiB, WS_WPOOL = 88 * MiB;
constexpr size_t WS_PB = 89 * MiB, WS_PPJ = 122 * MiB, WS_HB0 = 155 * MiB, WS_SSQA = 188 * MiB, WS_SSQB = 190 * MiB, WS_SSQEA = WS_SSQA + 3 * MiB / 2, WS_SSQEB = WS_SSQB + 3 * MiB / 2;
constexpr size_t WS_ACT = 192 * MiB, WS_DQ = WS_ACT, WS_HB1 = WS_ACT + 33 * MiB;
constexpr size_t WS_KB = 283 * MiB, WS_VT = 292 * MiB, WS_KEXT = 301 * MiB, WS_VEXT = 311 * MiB, WS_UH = 321 * MiB, WS_END = 327 * MiB;
constexpr int KEXT_ROWS = 160;
constexpr int NB32 = T / 32;
__device__ __forceinline__ size_t kf_off(int kvh, int blk, int key, int e0) { return ((size_t)(kvh * NB32 + blk) * 2048) + (((e0 >> 4) * 2 + ((e0 >> 3) & 1)) * 32 + key) * 8; }
__device__ __forceinline__ size_t kxf_off(int sq, int kvh, int blk, int key, int e0) { return ((size_t)((sq * 4 + kvh) * 5 + blk) * 2048) + (((e0 >> 4) * 2 + ((e0 >> 3) & 1)) * 32 + key) * 8; }
__device__ __forceinline__ size_t vf_blk(int db, int s2, int hh, int dl) { return (size_t)((((db * 2 + s2) * 2 + hh) * 32 + dl) * 8); }
constexpr int CW_BAR = 4096;
constexpr int RING_BYTES = 131072, MISC_OFF = RING_BYTES + 320, SCR_OFF = RING_BYTES + 512, LDS_BYTES = 163840;
constexpr int SSQL_OFF = SCR_OFF + 13312;
static_assert(SSQL_OFF + 16384 <= LDS_BYTES, "LDS map");
constexpr int NWAVES = 8;
constexpr int NPHASES = 22;

__device__ __forceinline__ unsigned pk2(float lo, float hi) { f32x2 v = {lo, hi}; bf16x2_t b = __builtin_convertvector(v, bf16x2_t); return __builtin_bit_cast(unsigned, b); }
__device__ __forceinline__ float bf_lo(unsigned w) { return __builtin_bit_cast(float, w << 16); }
__device__ __forceinline__ float bf_hi(unsigned w) { return __builtin_bit_cast(float, w & 0xffff0000u); }
template <int CTRL> __device__ __forceinline__ float dppm(float x) { return __builtin_bit_cast(float, __builtin_amdgcn_update_dpp(0, __builtin_bit_cast(int, x), CTRL, 0xf, 0xf, false)); }
__device__ __forceinline__ float xor16_other(float x) { auto r = __builtin_amdgcn_permlane16_swap(__builtin_bit_cast(unsigned, x), __builtin_bit_cast(unsigned, x), false, false); const float a = __builtin_bit_cast(float, (unsigned)r[0]), b = __builtin_bit_cast(float, (unsigned)r[1]); return a + b - x; }
__device__ __forceinline__ float sum_x16(float x) { auto r = __builtin_amdgcn_permlane16_swap(__builtin_bit_cast(unsigned, x), __builtin_bit_cast(unsigned, x), false, false); return __builtin_bit_cast(float, (unsigned)r[0]) + __builtin_bit_cast(float, (unsigned)r[1]); }
__device__ __forceinline__ float sum_x32(float x) { auto r = __builtin_amdgcn_permlane32_swap(__builtin_bit_cast(unsigned, x), __builtin_bit_cast(unsigned, x), false, false); return __builtin_bit_cast(float, (unsigned)r[0]) + __builtin_bit_cast(float, (unsigned)r[1]); }
__device__ __forceinline__ float max_x32(float x) { auto r = __builtin_amdgcn_permlane32_swap(__builtin_bit_cast(unsigned, x), __builtin_bit_cast(unsigned, x), false, false); return fmaxf(__builtin_bit_cast(float, (unsigned)r[0]), __builtin_bit_cast(float, (unsigned)r[1])); }
__device__ __forceinline__ float row16_sum(float v) {
    v += dppm<0xB1>(v); v += dppm<0x4E>(v); v += dppm<0x141>(v); v += dppm<0x128>(v); return v;
}
__device__ __forceinline__ float wave_sum(float v) { v = row16_sum(v); v = sum_x16(v); v = sum_x32(v); return v; }
template <int CTRL> __device__ __forceinline__ float dppz(float x) { return __builtin_bit_cast(float, __builtin_amdgcn_update_dpp(0, __builtin_bit_cast(int, x), CTRL, 0xf, 0xf, true)); }
template <int SHR, int SHL> __device__ __forceinline__ float dpp2(float cur, float prev) {
    const int o = __builtin_amdgcn_update_dpp(0, __builtin_bit_cast(int, prev), SHL, 0xf, 0xf, true);
    return __builtin_bit_cast(float, __builtin_amdgcn_update_dpp(o, __builtin_bit_cast(int, cur), SHR, 0xf, 0xf, false));
}
template <int CTRL> __device__ __forceinline__ float dpp_old(float x, float old) { return __builtin_bit_cast(float, __builtin_amdgcn_update_dpp(__builtin_bit_cast(int, old), __builtin_bit_cast(int, x), CTRL, 0xf, 0xf, false)); }
__device__ __forceinline__ float rsq(float x) { return __builtin_amdgcn_rsqf(x); }
__device__ __forceinline__ float row_rstd(const float* ssq, int row) {
    const f32x4* p = (const f32x4*)(ssq + (size_t)row * 16);
    const f32x4 a = p[0], b = p[1], c = p[2], d = p[3];
    const float s = ((a.x + a.y) + (a.z + a.w)) + ((b.x + b.y) + (b.z + b.w)) + ((c.x + c.y) + (c.z + c.w)) + ((d.x + d.y) + (d.z + d.w));
    return rsq(s * (1.0f / 1024.0f) + EPS);
}
__device__ __forceinline__ float row_rstd4(const float* ssq, int row, int fq) {
    const f32x4 a = *(const f32x4*)(ssq + (size_t)row * 16 + 4 * fq);
    float s = (a.x + a.y) + (a.z + a.w);
    s = sum_x16(s); s = sum_x32(s);
    return rsq(s * (1.0f / 1024.0f) + EPS);
}
__device__ __forceinline__ float rstdE(const GAS float* ssqE, int sr, int fq) {
    const f32x4 a = *(const GAS f32x4*)(ssqE + (size_t)sr * 32 + 8 * fq), b = *(const GAS f32x4*)(ssqE + (size_t)sr * 32 + 8 * fq + 4);
    float s = ((a.x + a.y) + (a.z + a.w)) + ((b.x + b.y) + (b.z + b.w));
    s = sum_x16(s); s = sum_x32(s);
    return rsq(s * (1.0f / 1024.0f) + EPS);
}
#define CFENCE() asm volatile("" ::: "memory")
#define SFENCE() do { asm volatile("" ::: "memory"); __builtin_amdgcn_sched_barrier(0); } while (0)
__device__ __forceinline__ float gelu_tanh(float x) {
    const float inner = x * (1.0f + 0.044715f * x * x);
    const float t = __builtin_amdgcn_exp2f(-2.3022082f * inner);
    return x * __builtin_amdgcn_rcpf(1.0f + t);
}
__device__ __forceinline__ f32x2 gelu_tanh2(f32x2 x) {
    const f32x2 inner = x * (x * x * 0.044715f + 1.0f);
    const f32x2 z = inner * (-2.3022082f);
    f32x2 t; t.x = __builtin_amdgcn_exp2f(z.x); t.y = __builtin_amdgcn_exp2f(z.y);
    const f32x2 d = t + 1.0f;
    f32x2 r; r.x = __builtin_amdgcn_rcpf(d.x); r.y = __builtin_amdgcn_rcpf(d.y);
    return x * r;
}
__device__ __forceinline__ f32x4 gelu_tanh4(f32x4 v) { const f32x2 a = gelu_tanh2((f32x2){v.x, v.y}), b = gelu_tanh2((f32x2){v.z, v.w}); return (f32x4){a.x, a.y, b.x, b.y}; }
__device__ __forceinline__ float sigmoidf_(float x) { return __builtin_amdgcn_rcpf(1.0f + __builtin_amdgcn_exp2f(-LOG2E * x)); }
__device__ __forceinline__ int lane_id() { int l; asm volatile("v_mbcnt_lo_u32_b32 %0, -1, 0\n\tv_mbcnt_hi_u32_b32 %0, -1, %0" : "=v"(l)); return l; }
#define LDS_WAIT() asm volatile("s_waitcnt lgkmcnt(0)" ::: "memory")
#define VM_WAIT() asm volatile("s_waitcnt vmcnt(0)" ::: "memory")

__device__ __forceinline__ unsigned long long uni64(const char* p) {
    const unsigned long long v = (unsigned long long)p;
    return ((unsigned long long)(unsigned)__builtin_amdgcn_readfirstlane((int)(v >> 32)) << 32) | (unsigned)__builtin_amdgcn_readfirstlane((int)v);
}
__device__ __forceinline__ void glds16(const char* sbase_, unsigned voff, unsigned ldsdst) {
    unsigned keep; const unsigned long long sbase = uni64(sbase_);
    asm volatile("s_nop 4\n\ts_mov_b32 %0, m0\n\ts_mov_b32 m0, %3\n\ts_nop 0\n\tglobal_load_lds_dwordx4 %2, %1\n\ts_mov_b32 m0, %0" : "=&s"(keep) : "s"(sbase), "v"(voff), "s"(ldsdst) : "memory");
}
__device__ __forceinline__ void glds4(const char* sbase_, unsigned voff, unsigned ldsdst) {
    unsigned keep; const unsigned long long sbase = uni64(sbase_);
    asm volatile("s_nop 4\n\ts_mov_b32 %0, m0\n\ts_mov_b32 m0, %3\n\ts_nop 0\n\tglobal_load_lds_dword %2, %1\n\ts_mov_b32 m0, %0" : "=&s"(keep) : "s"(sbase), "v"(voff), "s"(ldsdst) : "memory");
}
namespace pg8 {
constexpr int BM = 256, BK = 64, HALF = 128, HTB = HALF * BK * 2, STAGE_BYTES = 8 * HTB, NXCD = 8, WGM = 8;
__host__ __device__ __forceinline__ int lds_byte(int r, int c) { const int st = (r >> 4) * 2 + (c >> 5), rr = r & 15, cc = c & 31, ob = rr * 64 + cc * 2; return st * 1024 + (ob ^ (((ob >> 9) & 1) << 5)); }
__host__ __device__ __forceinline__ void stage_rc(int b, int& R, int& C) { const int st = b / 1024, sb = b % 1024, swz = sb ^ (((sb >> 9) & 1) << 5); R = (st >> 1) * 16 + swz / 64; C = (st & 1) * 32 + (swz % 64) / 2; }
__host__ __device__ __forceinline__ int perm32(int rho) { const int n = rho >> 4, i = rho & 15; return 8 * (i >> 2) + 4 * n + (i & 3); }

struct Unit { int pm, pn; };
struct Gemm { const bf16_t* A; const bf16_t* Bt; int lda, ldb, K, a_pn; const bf16_t* AE; };

struct StaticOrder {
    int nM, nN, nwg, G, c;
    __device__ __forceinline__ void init(int M, int N, int G_, int c_) { nM = M / BM; nN = N / BM; nwg = nM * nN; G = G_; c = c_; }
    __device__ __forceinline__ bool next(int i, Unit& u) const {
        const int L = __builtin_amdgcn_readfirstlane(i * G + c); if (L < 0 || L >= nwg) return false;
        int wgid = L; { const int q = nwg / NXCD, r = nwg % NXCD, xcd = wgid % NXCD, off = wgid / NXCD; wgid = (xcd < r ? xcd * (q + 1) : r * (q + 1) + (xcd - r) * q) + off; }
        const int nig = WGM * nN, gid = wgid / nig, fm = gid * WGM, gsz = (nM - fm) < WGM ? (nM - fm) : WGM;
        u.pm = __builtin_amdgcn_readfirstlane(fm + ((wgid % nig) % gsz)); u.pn = __builtin_amdgcn_readfirstlane((wgid % nig) / gsz); return true;
    }
};

template <class Epi, bool ER, bool PA = false>
__device__ __forceinline__ void gemm_phase(LAS unsigned char* lds, LAS unsigned char* ebuf, const int tid, const Gemm g, const int M_, const int N_, const int G_, const int c_, const Epi& E) {
    StaticOrder S; S.init(M_, N_, G_, c_);
    const int wid = __builtin_amdgcn_readfirstlane(tid >> 6), lane = tid & 63, wr = wid >> 2, wc = wid & 3, fr = lane & 15, fq = lane >> 4;
    const int K = g.K, nt = K / BK;
    unsigned voffA, voffB;
    { int R, C; stage_rc(tid * 16, R, C); const int Rb = (R & ~31) + perm32(R & 31); const int Ra = PA ? (R & ~63) + 4 * (R & 15) + ((R >> 4) & 3) : R; voffA = (unsigned)(Ra * g.lda + C) * 2u; voffB = (unsigned)(Rb * g.ldb + C) * 2u; }
    const unsigned dvoffA = (unsigned)(64 * g.lda * 2), dvoffB = (unsigned)(64 * g.ldb * 2);
    const unsigned voffE = (unsigned)((tid >> 5) * g.lda) * 2u + (unsigned)(tid & 31) * 4u;
    const size_t kstep = (size_t)(BK * 2);
    const size_t hstepA = (size_t)HALF * g.lda * 2, hstepB = (size_t)HALF * g.ldb * 2;
    const size_t tstepA = 2 * hstepA, tstepB = 2 * hstepB;
    const size_t estep = (size_t)8 * g.lda * 2;
    const unsigned ldsw = (unsigned)wid * 1024u;
    const unsigned ldsbase = (unsigned)(uintptr_t)lds, ebase = (unsigned)(uintptr_t)ebuf;
#define PG8_SA(b, h) (((b) * 2 + (h)) * HTB)
#define PG8_SB(b, h) ((4 + (b) * 2 + (h)) * HTB)
#define PG8_STAGE(bufoff, gbase, voff) do { \
        glds16((const char*)(gbase), voff, (unsigned)__builtin_amdgcn_readfirstlane((int)(ldsbase + (unsigned)(bufoff) + ldsw))); \
        glds16((const char*)(gbase) + d##voff, voff, (unsigned)__builtin_amdgcn_readfirstlane((int)(ldsbase + (unsigned)(bufoff) + ldsw + 8192u))); } while (0)
#define PG8_ESTAGE(b, gbase) do { if constexpr (ER) glds4((const char*)(gbase), voffE, (unsigned)__builtin_amdgcn_readfirstlane((int)(ebase + (unsigned)((b) * 2048) + (unsigned)wid * 256u))); } while (0)
#define PG8_LDA(dst, b, h) do { _Pragma("unroll") for (int m = 0; m < 4; ++m) _Pragma("unroll") for (int k = 0; k < 2; ++k) dst[m][k] = *(const LAS bf16x8*)(lds + PG8_SA(b, h) + aoff + m * 2048 + k * 1024); } while (0)
#define PG8_LDB(dst, b, h) do { _Pragma("unroll") for (int n = 0; n < 2; ++n) _Pragma("unroll") for (int k = 0; k < 2; ++k) dst[n][k] = *(const LAS bf16x8*)(lds + PG8_SB(b, 0) + ((h) ? boff1 : boff0) + n * 2048 + k * 1024); } while (0)
#define PG8_LDE(b) do { if constexpr (ER) { Et[0] = *(const LAS bf16x8*)(ebuf + (b) * 2048 + eoff); Et[1] = *(const LAS bf16x8*)(ebuf + (b) * 2048 + eoff + 64); } } while (0)
#define PG8_MMA(ai, bj, At, Bt) do { __builtin_amdgcn_s_setprio(1); _Pragma("unroll") for (int m = 0; m < 4; ++m) _Pragma("unroll") for (int n = 0; n < 2; ++n) _Pragma("unroll") for (int k = 0; k < 2; ++k) \
        acc[ai][bj][m][n] = __builtin_amdgcn_mfma_f32_16x16x32_bf16(Bt[n][k], At[m][k], acc[ai][bj][m][n], 0, 0, 0); __builtin_amdgcn_s_setprio(0); } while (0)
#define PG8_EMMA() do { if constexpr (ER) { _Pragma("unroll") for (int n = 0; n < 2; ++n) _Pragma("unroll") for (int k = 0; k < 2; ++k) accE[n] = __builtin_amdgcn_mfma_f32_16x16x32_bf16(B0[n][k], Et[k], accE[n], 0, 0, 0); } } while (0)
#define PG8_WAIT_V(n) asm volatile("s_waitcnt vmcnt(" #n ")" ::: "memory")
#define PG8_WAIT_VL() do { if constexpr (ER) PG8_WAIT_V(9); else PG8_WAIT_V(8); } while (0)
#define PG8_WAIT_L(n) asm volatile("s_waitcnt lgkmcnt(" #n ")" ::: "memory")
#define PG8_BAR __builtin_amdgcn_s_barrier()
#define PG8_SCHED __builtin_amdgcn_sched_barrier(0)
    Unit cur{0, 0}, nxt{0, 0}; int ui = 0;
    if (!S.next(0, cur)) return;
    f32x4 acc[2][2][4][2]; f32x4 accE[2];
    { float z0 = 0.f; asm volatile("" : "+v"(z0));
#pragma unroll
    for (int a = 0; a < 2; ++a)
#pragma unroll
        for (int b = 0; b < 2; ++b)
#pragma unroll
            for (int m = 0; m < 4; ++m)
#pragma unroll
                for (int n = 0; n < 2; ++n) acc[a][b][m][n] = (f32x4){z0, z0, z0, z0};
    accE[0] = (f32x4){z0, z0, z0, z0}; accE[1] = (f32x4){z0, z0, z0, z0}; }
    bf16x8 At[4][2], B0[2][2], B1[2][2], Et[2];
    const char* cA = (const char*)g.A + (size_t)cur.pm * tstepA + (size_t)cur.pn * g.a_pn * 2; const char* cB = (const char*)g.Bt + (size_t)cur.pn * tstepB;
    const char* cE = (const char*)g.AE + (size_t)cur.pm * estep + (size_t)cur.pn * g.a_pn * 2;
    if constexpr (Epi::SSQL) { if (cur.pm < 64) { const char* sp = (const char*)E.ssq_panel(cur.pm);
        glds16(sp, (unsigned)tid * 16u, (unsigned)__builtin_amdgcn_readfirstlane((int)(ldsbase + (unsigned)SSQL_OFF + ldsw)));
        glds16(sp + 8192, (unsigned)tid * 16u, (unsigned)__builtin_amdgcn_readfirstlane((int)(ldsbase + (unsigned)SSQL_OFF + 8192u + ldsw))); } }
    PG8_STAGE(PG8_SB(0, 0), cB, voffB); PG8_STAGE(PG8_SB(0, 1), cB + hstepB, voffB); PG8_STAGE(PG8_SA(0, 0), cA, voffA); PG8_STAGE(PG8_SA(0, 1), cA + hstepA, voffA); PG8_ESTAGE(0, cE);
    if (wr == 1) PG8_BAR;
    if constexpr (ER) PG8_WAIT_V(3); else PG8_WAIT_V(2);
    PG8_BAR;
    PG8_STAGE(PG8_SB(1, 0), cB + kstep, voffB); PG8_STAGE(PG8_SA(1, 0), cA + kstep, voffA); PG8_STAGE(PG8_SB(1, 1), cB + hstepB + kstep, voffB);
    PG8_WAIT_V(6); PG8_BAR;
    const int l1 = lane_id(), fr1 = l1 & 15, fq1 = l1 >> 4;
    const int aoff = lds_byte(wr * 64 + fr1, fq1 * 8), boff = lds_byte(wc * 32 + fr1, fq1 * 8);
    const int eoff = fr1 * 128 + fq1 * 16;
    for (;;) {
        const bool has_next = S.next(ui + 1, nxt);
        const char* nA = has_next ? (const char*)g.A + (size_t)nxt.pm * tstepA + (size_t)nxt.pn * g.a_pn * 2 : cA; const char* nB = has_next ? (const char*)g.Bt + (size_t)nxt.pn * tstepB : cB;
        const char* nE = has_next ? (const char*)g.AE + (size_t)nxt.pm * estep + (size_t)nxt.pn * g.a_pn * 2 : cE;
#pragma nounroll
        for (int t = 0; t < nt; t += 2) {
            int o0 = ER ? wr * HTB : 0; if constexpr (ER) asm volatile("" : "+s"(o0));
            const int boff0 = boff + o0, boff1 = boff0 + (HTB - 2 * o0);
            const bool last = (t == nt - 2);
            const char* a1 = cA + (size_t)(t + 1) * kstep;
            const char* a2 = last ? nA : cA + (size_t)(t + 2) * kstep; const char* b2 = last ? nB : cB + (size_t)(t + 2) * kstep;
            const char* a3 = a2 + kstep; const char* b3 = b2 + kstep;
            const char* e1 = cE + (size_t)(t + 1) * kstep; const char* e2 = last ? nE : cE + (size_t)(t + 2) * kstep;
            PG8_LDB(B0, 0, 0); PG8_LDB(B1, 0, 1); PG8_SCHED; PG8_LDA(At, 0, 0); PG8_STAGE(PG8_SA(1, 1), a1 + hstepA, voffA); PG8_ESTAGE(1, e1);
            PG8_WAIT_VL(); PG8_WAIT_L(0); PG8_BAR; PG8_MMA(0, 0, At, B0); PG8_MMA(0, 1, At, B1); PG8_BAR; PG8_SCHED;
            PG8_LDA(At, 0, 1); PG8_LDE(0); PG8_STAGE(PG8_SB(0, 0), b2, voffB); PG8_STAGE(PG8_SB(0, 1), b2 + hstepB, voffB); PG8_STAGE(PG8_SA(0, 0), a2, voffA);
            PG8_WAIT_VL(); PG8_WAIT_L(0); PG8_BAR; PG8_MMA(1, 0, At, B0); PG8_MMA(1, 1, At, B1); PG8_EMMA(); PG8_BAR; PG8_SCHED;
            PG8_LDB(B0, 1, 0); PG8_LDB(B1, 1, 1); PG8_SCHED; PG8_LDA(At, 1, 0); PG8_STAGE(PG8_SA(0, 1), a2 + hstepA, voffA); PG8_ESTAGE(0, e2);
            PG8_WAIT_VL(); PG8_WAIT_L(0); PG8_BAR; PG8_MMA(0, 0, At, B0); PG8_MMA(0, 1, At, B1); PG8_BAR; PG8_SCHED;
            PG8_LDA(At, 1, 1); PG8_LDE(1); PG8_STAGE(PG8_SB(1, 0), b3, voffB); PG8_STAGE(PG8_SB(1, 1), b3 + hstepB, voffB); PG8_STAGE(PG8_SA(1, 0), a3, voffA);
            PG8_WAIT_VL(); PG8_WAIT_L(0); PG8_BAR; PG8_MMA(1, 0, At, B0); PG8_MMA(1, 1, At, B1); PG8_EMMA(); PG8_BAR; PG8_SCHED;
        }
        if (wr == 0) PG8_BAR;
        { const int l2 = lane_id(); if constexpr (Epi::SSQL) E(acc, accE, cur, wr, wc, l2 & 15, l2 >> 4, has_next ? nxt.pm : -1, ldsbase, wid); else E(acc, accE, cur, wr, wc, l2 & 15, l2 >> 4); }
        if (!has_next) break;
        { float z0 = 0.f; asm volatile("" : "+v"(z0));
#pragma unroll
        for (int a = 0; a < 2; ++a)
#pragma unroll
            for (int b = 0; b < 2; ++b)
#pragma unroll
                for (int m = 0; m < 4; ++m)
#pragma unroll
                    for (int n = 0; n < 2; ++n) acc[a][b][m][n] = (f32x4){z0, z0, z0, z0};
        accE[0] = (f32x4){z0, z0, z0, z0}; accE[1] = (f32x4){z0, z0, z0, z0}; }
        cur = nxt; cA = nA; cB = nB; cE = nE; ++ui;
        if (wr == 1) PG8_BAR;
    }
    PG8_WAIT_V(0);
    PG8_BAR;
#undef PG8_SA
#undef PG8_SB
#undef PG8_STAGE
#undef PG8_ESTAGE
#undef PG8_LDA
#undef PG8_LDB
#undef PG8_LDE
#undef PG8_MMA
#undef PG8_EMMA
#undef PG8_WAIT_V
#undef PG8_WAIT_VL
#undef PG8_WAIT_L
#undef PG8_BAR
#undef PG8_SCHED
}
}
using pg8::Unit;

struct Bases { const float* const* in; float* out; unsigned char* ws; };
template <class P> __device__ __forceinline__ P opaque_uniform(P p) {
    unsigned long long v = (unsigned long long)p; unsigned lo = __builtin_amdgcn_readfirstlane((unsigned)v), hi = __builtin_amdgcn_readfirstlane((unsigned)(v >> 32));
    asm volatile("" : "+s"(lo), "+s"(hi)); return (P)(((unsigned long long)hi << 32) | lo);
}
#define EPI_BASES(B) const float* const* in_ = (B).in; float* out0_ = (B).out; unsigned char* ws0_ = (B).ws; asm volatile("" : "+s"(out0_), "+s"(ws0_)); GAS float* const out_ = (GAS float*)out0_; GAS unsigned char* const ws_ = (GAS unsigned char*)ws0_; (void)in_; (void)out_; (void)ws_
__device__ __forceinline__ void ld_res8(const GAS void* base, bool f32src, size_t eoff, f32x4& a, f32x4& b) {
    if (f32src) { const GAS float* p = (const GAS float*)base + eoff; a = *(const GAS f32x4*)p; b = *(const GAS f32x4*)(p + 4); }
    else { const u32x4 w = *(const GAS u32x4*)((const GAS bf16_t*)base + eoff); a = (f32x4){bf_lo(w.x), bf_hi(w.x), bf_lo(w.y), bf_hi(w.y)}; b = (f32x4){bf_lo(w.z), bf_hi(w.z), bf_lo(w.w), bf_hi(w.w)}; }
}
struct EpiRes {
    static constexpr bool SSQL = false;
    Bases B; int src; int dry;
    template <bool F32, int NB>
    __device__ __forceinline__ void run(f32x4 (&acc)[2][2][4][2], f32x4 (&accE)[2], const Unit& u, int wr, int wc, int fr, int fq, const GAS void* rin_p, const GAS void* rin_s, GAS bf16_t* hb, GAS float* ssq, GAS float* ssqE) const {
        const int colb = u.pn * 256 + wc * 32 + 8 * fq;
        const int row0 = u.pm * 256 + wr * 64 + fr;
        const int sr = u.pm * 8 + (fr & 7), colE = colb + wr * 128;
        f32x4 e0, e1; ld_res8(rin_s, F32, (size_t)sr * D + colE, e0, e1);
        float sg[8];
#pragma unroll
        for (int b0 = 0; b0 < 8; b0 += NB) {
            f32x4 rf[F32 ? NB : 1][4]; u32x4 rb[F32 ? 1 : NB][2];
#pragma unroll
            for (int i = 0; i < NB; ++i) {
                const int g = b0 + i; const size_t ro = (size_t)(row0 + (g >> 2) * 128 + (g & 3) * 16) * D + colb;
#pragma unroll
                for (int bj = 0; bj < 2; ++bj) {
                    if (F32) { const GAS float* p = (const GAS float*)rin_p + ro + (bj ^ wr) * 128; rf[F32 ? i : 0][2 * bj] = *(const GAS f32x4*)p; rf[F32 ? i : 0][2 * bj + 1] = *(const GAS f32x4*)(p + 4); }
                    else rb[F32 ? 0 : i][bj] = *(const GAS u32x4*)((const GAS bf16_t*)rin_p + ro + (bj ^ wr) * 128);
                }
            }
            CFENCE();
#pragma unroll
            for (int i = 0; i < NB; ++i) {
                const int g = b0 + i, ai = g >> 2, m = g & 3;
                const int row = row0 + ai * 128 + m * 16;
                float s = 0.f;
#pragma unroll
                for (int bj = 0; bj < 2; ++bj) {
                    const int col = colb + (bj ^ wr) * 128;
                    f32x4 c0, c1;
                    if (F32) { c0 = rf[F32 ? i : 0][2 * bj]; c1 = rf[F32 ? i : 0][2 * bj + 1]; }
                    else { const u32x4 w = rb[F32 ? 0 : i][bj]; c0 = (f32x4){bf_lo(w.x), bf_hi(w.x), bf_lo(w.y), bf_hi(w.y)}; c1 = (f32x4){bf_lo(w.z), bf_hi(w.z), bf_lo(w.w), bf_hi(w.w)}; }
                    const f32x4 v0 = acc[ai][bj][m][0] + c0, v1 = acc[ai][bj][m][1] + c1;
                    u32x4 w; w.x = pk2(v0.x, v0.y); w.y = pk2(v0.z, v0.w); w.z = pk2(v1.x, v1.y); w.w = pk2(v1.z, v1.w);
                    if (!dry) *(GAS u32x4*)(hb + (size_t)row * D + col) = w;
                    s += (v0.x * v0.x + v0.y * v0.y) + (v0.z * v0.z + v0.w * v0.w) + (v1.x * v1.x + v1.y * v1.y) + (v1.z * v1.z + v1.w * v1.w);
                }
                s = sum_x16(s); s = sum_x32(s);
                sg[g] = s;
            }
            CFENCE();
        }
        if (!dry) {
#pragma unroll
            for (int ai = 0; ai < 2; ++ai) {
                const float v = fq == 0 ? sg[4 * ai] : (fq == 1 ? sg[4 * ai + 1] : (fq == 2 ? sg[4 * ai + 2] : sg[4 * ai + 3]));
                ssq[(size_t)(row0 + ai * 128 + fq * 16) * 16 + u.pn * 4 + wc] = v;
            }
        }
        {
            const f32x4 v0 = accE[0] + e0, v1 = accE[1] + e1;
            u32x4 w; w.x = pk2(v0.x, v0.y); w.y = pk2(v0.z, v0.w); w.z = pk2(v1.x, v1.y); w.w = pk2(v1.z, v1.w);
            float q = (v0.x * v0.x + v0.y * v0.y) + (v0.z * v0.z + v0.w * v0.w) + (v1.x * v1.x + v1.y * v1.y) + (v1.z * v1.z + v1.w * v1.w);
            q = sum_x16(q); q = sum_x32(q);
            if (fr < 8 && !dry) {
                *(GAS u32x4*)(hb + (size_t)(TP + sr) * D + colE) = w;
                if (fq == 0) ssqE[(size_t)sr * 32 + (u.pn * 4 + wc) * 2 + wr] = q;
            }
        }
    }
    __device__ __forceinline__ void operator()(f32x4 (&acc)[2][2][4][2], f32x4 (&accE)[2], const Unit& u, int wr, int wc, int fr, int fq) const {
        EPI_BASES(B);
        const bool f32src = (src == 0);
        const GAS void* rin_p = f32src ? (const GAS void*)in_[I_XP] : (const GAS void*)(ws_ + (src == 1 ? WS_HB1 : WS_HB0));
        const GAS void* rin_s = f32src ? (const GAS void*)in_[I_XS] : (const GAS void*)((const GAS bf16_t*)rin_p + (size_t)TP * D);
        GAS bf16_t* hb = (GAS bf16_t*)(ws_ + WS_HB0); GAS float* ssq = (GAS float*)(ws_ + WS_SSQA); GAS float* ssqE = (GAS float*)(ws_ + WS_SSQEA);
        if (f32src) run<true, 2>(acc, accE, u, wr, wc, fr, fq, rin_p, rin_s, hb, ssq, ssqE);
        else run<false, 4>(acc, accE, u, wr, wc, fr, fq, rin_p, rin_s, hb, ssq, ssqE);
    }
};
struct EpiBf16 {
    static constexpr bool SSQL = false;
    Bases B;
    __device__ __forceinline__ void operator()(f32x4 (&acc)[2][2][4][2], f32x4 (&accE)[2], const Unit& u, int wr, int wc, int fr, int fq) const {
        EPI_BASES(B);
        GAS bf16_t* O = (GAS bf16_t*)(ws_ + WS_PPJ); constexpr int ldc = D;
        const int colb = u.pn * 256 + wc * 32 + 8 * fq;
#pragma unroll
        for (int ai = 0; ai < 2; ++ai)
#pragma unroll
            for (int m = 0; m < 4; ++m) {
                const int row = u.pm * 256 + ai * 128 + wr * 64 + m * 16 + fr;
#pragma unroll
                for (int bj = 0; bj < 2; ++bj) {
                    const f32x4 v0 = acc[ai][bj][m][0], v1 = acc[ai][bj][m][1];
                    u32x4 w; w.x = pk2(v0.x, v0.y); w.y = pk2(v0.z, v0.w); w.z = pk2(v1.x, v1.y); w.w = pk2(v1.z, v1.w);
                    *(GAS u32x4*)(O + (size_t)row * ldc + colb + (bj ^ wr) * 128) = w;
                }
            }
        if (fr < 8) {
            const f32x4 v0 = accE[0], v1 = accE[1];
            u32x4 w; w.x = pk2(v0.x, v0.y); w.y = pk2(v0.z, v0.w); w.z = pk2(v1.x, v1.y); w.w = pk2(v1.z, v1.w);
            *(GAS u32x4*)(O + (size_t)(TP + u.pm * 8 + fr) * ldc + colb + wr * 128) = w;
        }
    }
};
struct EpiPle {
    static constexpr bool SSQL = false;
    Bases B; int write_hb; int last; int dry;
    __device__ __forceinline__ void operator()(f32x4 (&acc)[2][2][4][2], f32x4 (&accE)[2], const Unit& u, int wr, int wc, int fr, int fq) const {
        EPI_BASES(B);
        const GAS float* ssq = (const GAS float*)(ws_ + WS_SSQA); const GAS bf16_t* pp = (const GAS bf16_t*)(ws_ + WS_PPJ); const GAS bf16_t* hin = (const GAS bf16_t*)(ws_ + WS_HB0); GAS bf16_t* hb1 = (GAS bf16_t*)(ws_ + WS_HB1); GAS float* y = out_;
        GAS float* ssq_out = (GAS float*)(ws_ + WS_SSQB); const GAS float* ssqE = (const GAS float*)(ws_ + WS_SSQEA); GAS float* ssqE_out = (GAS float*)(ws_ + WS_SSQEB);
        const int colb = u.pn * 256 + wc * 32 + 8 * fq;
        const int row0 = u.pm * 256 + wr * 64 + fr;
#pragma unroll
        for (int b0 = 0; b0 < 8; b0 += 2) {
            f32x4 bsq[2]; u32x4 bh[2][2], bp[2][2];
#pragma unroll
            for (int i = 0; i < 2; ++i) {
                const int g = b0 + i, r1 = row0 + (g >> 2) * 128 + (g & 3) * 16;
                bsq[i] = *(const GAS f32x4*)(ssq + (size_t)r1 * 16 + 4 * fq);
#pragma unroll
                for (int bj = 0; bj < 2; ++bj) { const size_t o = (size_t)r1 * D + colb + (bj ^ wr) * 128; bh[i][bj] = *(const GAS u32x4*)(hin + o); bp[i][bj] = *(const GAS u32x4*)(pp + o); }
            }
            CFENCE();
#pragma unroll
            for (int i = 0; i < 2; ++i) {
                const int g = b0 + i, ai = g >> 2, m = g & 3;
                const int row = row0 + ai * 128 + m * 16;
                const f32x4 csq = bsq[i];
                float rsg; { float q = (csq.x + csq.y) + (csq.z + csq.w); q = sum_x16(q); q = sum_x32(q); rsg = rsq(q * (1.0f / 1024.0f) + EPS); }
                float s = 0.f;
#pragma unroll
                for (int bj = 0; bj < 2; ++bj) {
                    const int col = colb + (bj ^ wr) * 128;
                    const u32x4 pw = bp[i][bj], hw = bh[i][bj];
                    const f32x4 a0 = acc[ai][bj][m][0] * rsg, a1 = acc[ai][bj][m][1] * rsg;
                    f32x4 v0, v1;
                    v0.x = bf_lo(hw.x) + sigmoidf_(a0.x) * bf_lo(pw.x); v0.y = bf_hi(hw.x) + sigmoidf_(a0.y) * bf_hi(pw.x);
                    v0.z = bf_lo(hw.y) + sigmoidf_(a0.z) * bf_lo(pw.y); v0.w = bf_hi(hw.y) + sigmoidf_(a0.w) * bf_hi(pw.y);
                    v1.x = bf_lo(hw.z) + sigmoidf_(a1.x) * bf_lo(pw.z); v1.y = bf_hi(hw.z) + sigmoidf_(a1.y) * bf_hi(pw.z);
                    v1.z = bf_lo(hw.w) + sigmoidf_(a1.z) * bf_lo(pw.w); v1.w = bf_hi(hw.w) + sigmoidf_(a1.w) * bf_hi(pw.w);
                    if (!dry) {
                        if (last) { GAS float* yp = y + (size_t)row * D + col; *(GAS f32x4*)yp = v0; *(GAS f32x4*)(yp + 4) = v1; }
                        else { u32x4 w; w.x = pk2(v0.x, v0.y); w.y = pk2(v0.z, v0.w); w.z = pk2(v1.x, v1.y); w.w = pk2(v1.z, v1.w); *(GAS u32x4*)(hb1 + (size_t)row * D + col) = w; }
                    }
                    if (write_hb) s += (v0.x * v0.x + v0.y * v0.y) + (v0.z * v0.z + v0.w * v0.w) + (v1.x * v1.x + v1.y * v1.y) + (v1.z * v1.z + v1.w * v1.w);
                }
                if (write_hb && !dry) {
                    s = sum_x16(s); s = sum_x32(s);
                    if (fq == 0) ssq_out[(size_t)row * 16 + u.pn * 4 + wc] = s;
                }
            }
            CFENCE();
        }
        {
            const int sr = u.pm * 8 + (fr & 7), colE = colb + wr * 128;
            const float rse = rstdE(ssqE, sr, fq);
            const size_t o = (size_t)(TP + sr) * D + colE;
            const u32x4 hw = *(const GAS u32x4*)(hin + o), pw = *(const GAS u32x4*)(pp + o);
            const f32x4 a0 = accE[0] * rse, a1 = accE[1] * rse;
            f32x4 v0, v1;
            v0.x = bf_lo(hw.x) + sigmoidf_(a0.x) * bf_lo(pw.x); v0.y = bf_hi(hw.x) + sigmoidf_(a0.y) * bf_hi(pw.x);
            v0.z = bf_lo(hw.y) + sigmoidf_(a0.z) * bf_lo(pw.y); v0.w = bf_hi(hw.y) + sigmoidf_(a0.w) * bf_hi(pw.y);
            v1.x = bf_lo(hw.z) + sigmoidf_(a1.x) * bf_lo(pw.z); v1.y = bf_hi(hw.z) + sigmoidf_(a1.y) * bf_hi(pw.z);
            v1.z = bf_lo(hw.w) + sigmoidf_(a1.z) * bf_lo(pw.w); v1.w = bf_hi(hw.w) + sigmoidf_(a1.w) * bf_hi(pw.w);
            float q = (v0.x * v0.x + v0.y * v0.y) + (v0.z * v0.z + v0.w * v0.w) + (v1.x * v1.x + v1.y * v1.y) + (v1.z * v1.z + v1.w * v1.w);
            q = sum_x16(q); q = sum_x32(q);
            if (fr < 8 && !dry) {
                if (last) { *(GAS f32x4*)(y + o) = v0; *(GAS f32x4*)(y + o + 4) = v1; }
                else { u32x4 w; w.x = pk2(v0.x, v0.y); w.y = pk2(v0.z, v0.w); w.z = pk2(v1.x, v1.y); w.w = pk2(v1.z, v1.w); *(GAS u32x4*)(hb1 + o) = w; }
                if (write_hb && fq == 0) ssqE_out[(size_t)sr * 32 + (u.pn * 4 + wc) * 2 + wr] = q;
            }
        }
    }
};
struct EpiQ {
    static constexpr bool SSQL = false;
    Bases B; int jq; LAS float* XQ;
    __device__ __forceinline__ void operator()(f32x4 (&acc)[2][2][4][2], f32x4 (&accE)[2], const Unit& u, int wr, int wc, int fr, int fq) const {
        EPI_BASES(B);
        const GAS float* ssq = (const GAS float*)(ws_ + WS_SSQB); const GAS float* ssqE = (const GAS float*)(ws_ + WS_SSQEB); const GAS float* qn = (const GAS float*)in_[I_QN] + jq * 64;
        GAS bf16_t* Q = (GAS bf16_t*)(ws_ + WS_DQ);
        const int head = u.pn * 4 + wc;
        f32x4 nv[2][2];
#pragma unroll
        for (int bj = 0; bj < 2; ++bj)
#pragma unroll
            for (int n = 0; n < 2; ++n) nv[bj][n] = *(const GAS f32x4*)(qn + 32 * (bj ^ wr) + 8 * fq + 4 * n) * QSCALE;
        f32x4 nsq = *(const GAS f32x4*)(ssq + (size_t)(u.pm * 256 + wr * 64 + fr) * 16 + 4 * fq);
#pragma unroll
        for (int ai = 0; ai < 2; ++ai)
#pragma unroll
            for (int m = 0; m < 4; ++m) {
                const int row = u.pm * 256 + ai * 128 + wr * 64 + m * 16 + fr;
                const f32x4 csq = nsq;
                if (ai * 4 + m < 7) { const int g1 = ai * 4 + m + 1; nsq = *(const GAS f32x4*)(ssq + (size_t)(u.pm * 256 + (g1 >> 2) * 128 + wr * 64 + (g1 & 3) * 16 + fr) * 16 + 4 * fq); }
                CFENCE();
                float rs; { float q = (csq.x + csq.y) + (csq.z + csq.w); q = sum_x16(q); q = sum_x32(q); rs = rsq(q * (1.0f / 1024.0f) + EPS); }
                f32x4 v[2][2]; float ss = 0.f;
#pragma unroll
                for (int bj = 0; bj < 2; ++bj)
#pragma unroll
                    for (int n = 0; n < 2; ++n) { v[bj][n] = acc[ai][bj][m][n] * rs; const f32x4 x = v[bj][n]; ss += (x.x * x.x + x.y * x.y) + (x.z * x.z + x.w * x.w); }
                ss = sum_x16(ss); ss = sum_x32(ss);
                const float hr = rsq(ss * (1.0f / 64.0f) + EPS);
#pragma unroll
                for (int bj = 0; bj < 2; ++bj) {
                    const f32x4 o0 = v[bj][0] * hr * nv[bj][0], o1 = v[bj][1] * hr * nv[bj][1];
                    u32x4 w; w.x = pk2(o0.x, o0.y); w.y = pk2(o0.z, o0.w); w.z = pk2(o1.x, o1.y); w.w = pk2(o1.z, o1.w);
                    *(GAS u32x4*)(Q + (size_t)row * D + head * 64 + 32 * (bj ^ wr) + 8 * fq) = w;
                }
                CFENCE();
            }
        {
            const int sr = u.pm * 8 + (fr & 7);
            const float rse = rstdE(ssqE, sr, fq);
            const f32x4 v0 = accE[0] * rse, v1 = accE[1] * rse;
            float ss = (v0.x * v0.x + v0.y * v0.y) + (v0.z * v0.z + v0.w * v0.w) + (v1.x * v1.x + v1.y * v1.y) + (v1.z * v1.z + v1.w * v1.w);
            ss = sum_x16(ss); ss = sum_x32(ss);
            if (fq == 0) XQ[(wr * 4 + wc) * 16 + fr] = ss;
            LDS_WAIT(); __builtin_amdgcn_s_barrier(); CFENCE();
            ss += XQ[((1 - wr) * 4 + wc) * 16 + fr];
            const float hr = rsq(ss * (1.0f / 64.0f) + EPS);
            const f32x4 o0 = v0 * hr * nv[0][0], o1 = v1 * hr * nv[0][1];
            u32x4 w; w.x = pk2(o0.x, o0.y); w.y = pk2(o0.z, o0.w); w.z = pk2(o1.x, o1.y); w.w = pk2(o1.z, o1.w);
            if (fr < 8) *(GAS u32x4*)(Q + (size_t)(TP + sr) * D + head * 64 + 32 * wr + 8 * fq) = w;
            __builtin_amdgcn_s_barrier();
        }
    }
};
struct EpiK {
    static constexpr bool SSQL = false;
    Bases B;
    __device__ __forceinline__ void operator()(f32x4 (&acc)[2][2][4][2], f32x4 (&accE)[2], const Unit& u, int wr, int wc, int fr, int fq) const {
        EPI_BASES(B);
        const GAS float* ssq = (const GAS float*)(ws_ + WS_SSQB); const GAS float* ssqE = (const GAS float*)(ws_ + WS_SSQEB); const GAS float* kn = (const GAS float*)in_[I_KN];
        GAS bf16_t* Kb = (GAS bf16_t*)(ws_ + WS_KB); GAS bf16_t* Kext = (GAS bf16_t*)(ws_ + WS_KEXT); GAS float* out = out_;
        const bool sample = u.pm >= 64;
        const int head = wc;
        f32x4 nv[2][2];
#pragma unroll
        for (int bj = 0; bj < 2; ++bj)
#pragma unroll
            for (int n = 0; n < 2; ++n) nv[bj][n] = *(const GAS f32x4*)(kn + 32 * bj + 8 * fq + 4 * n);
        f32x4 sq[8];
#pragma unroll
        for (int g = 0; g < 8; ++g) {
            const int row = u.pm * 256 + (g >> 2) * 128 + wr * 64 + (g & 3) * 16 + fr;
            if (!sample) sq[g] = *(const GAS f32x4*)(ssq + (size_t)row * 16 + 4 * fq);
            else sq[g] = *(const GAS f32x4*)(ssqE + (size_t)(row - TP) * 32 + 8 * fq) + *(const GAS f32x4*)(ssqE + (size_t)(row - TP) * 32 + 8 * fq + 4);
        }
        float rsv[8];
#pragma unroll
        for (int g = 0; g < 8; ++g) { float q = (sq[g].x + sq[g].y) + (sq[g].z + sq[g].w); q = sum_x16(q); q = sum_x32(q); rsv[g] = rsq(q * (1.0f / 1024.0f) + EPS); }
#pragma unroll
        for (int ai = 0; ai < 2; ++ai)
#pragma unroll
            for (int m = 0; m < 4; ++m) {
                const int row = u.pm * 256 + ai * 128 + wr * 64 + m * 16 + fr;
                const float rs = rsv[ai * 4 + m];
                f32x4 v[2][2]; float ss = 0.f;
#pragma unroll
                for (int bj = 0; bj < 2; ++bj)
#pragma unroll
                    for (int n = 0; n < 2; ++n) { v[bj][n] = acc[ai][bj][m][n] * rs; const f32x4 x = v[bj][n]; ss += (x.x * x.x + x.y * x.y) + (x.z * x.z + x.w * x.w); }
                ss = sum_x16(ss); ss = sum_x32(ss);
                const float hr = rsq(ss * (1.0f / 64.0f) + EPS);
#pragma unroll
                for (int bj = 0; bj < 2; ++bj) {
                    const f32x4 o0 = v[bj][0] * hr * nv[bj][0], o1 = v[bj][1] * hr * nv[bj][1];
                    u32x4 w; w.x = pk2(o0.x, o0.y); w.y = pk2(o0.z, o0.w); w.z = pk2(o1.x, o1.y); w.w = pk2(o1.z, o1.w);
                    const int e0 = 32 * bj + 8 * fq;
                    if (!sample) {
                        *(GAS u32x4*)(Kb + kf_off(head, row >> 5, row & 31, e0)) = w;
                        const int t = row & (SEQ - 1);
                        if (t >= SEQ - 128) { GAS float* op = out + OFF_KP + ((size_t)((row >> 13) * 128 + (t - (SEQ - 128)))) * 256 + head * 64 + e0; *(GAS f32x4*)op = o0; *(GAS f32x4*)(op + 4) = o1; }
                    } else {
                        const int s = row - TP, sq = s >> 2, t = s & 3;
                        *(GAS u32x4*)(Kext + kxf_off(sq, head, 4, t, e0)) = w;
                        GAS float* op = out + OFF_KS + ((size_t)(sq * 128 + 124 + t)) * 256 + head * 64 + e0; *(GAS f32x4*)op = o0; *(GAS f32x4*)(op + 4) = o1;
                    }
                }
                CFENCE();
            }
    }
};
struct EpiVt {
    static constexpr bool SSQL = false;
    Bases B;
    __device__ __forceinline__ void operator()(f32x4 (&acc)[2][2][4][2], f32x4 (&accE)[2], const Unit& u, int wr, int wc, int fr, int fq) const {
        EPI_BASES(B);
        const GAS float* ssq = (const GAS float*)(ws_ + WS_SSQB); const GAS float* ssqE = (const GAS float*)(ws_ + WS_SSQEB); GAS bf16_t* Vt = (GAS bf16_t*)(ws_ + WS_VT); GAS bf16_t* Vext = (GAS bf16_t*)(ws_ + WS_VEXT); GAS float* out = out_;
        const int a = fq & 1;
#pragma unroll
        for (int bj = 0; bj < 2; ++bj) {
            const int tk0 = u.pn * 256 + bj * 128 + wc * 32 + 8 * fq;
            float rs[8];
#pragma unroll
            for (int e = 0; e < 8; ++e) {
                float q = (u.pn < 64) ? ssq[(size_t)(tk0 + e) * 16 + fr] : ssqE[(size_t)(tk0 + e - TP) * 32 + fr] + ssqE[(size_t)(tk0 + e - TP) * 32 + 16 + fr];
                q = row16_sum(q);
                rs[e] = rsq(q * (1.0f / 1024.0f) + EPS);
            }
            CFENCE();
#pragma unroll
            for (int ai = 0; ai < 2; ++ai)
#pragma unroll
                for (int m = 0; m < 4; ++m) {
                    const int d = ai * 128 + wr * 64 + m * 16 + fr;
                    f32x4 v0 = acc[ai][bj][m][0], v1 = acc[ai][bj][m][1];
                    v0.x *= rs[0]; v0.y *= rs[1]; v0.z *= rs[2]; v0.w *= rs[3]; v1.x *= rs[4]; v1.y *= rs[5]; v1.z *= rs[6]; v1.w *= rs[7];
                    u32x2 w0, w1; w0.x = pk2(v0.x, v0.y); w0.y = pk2(v0.z, v0.w); w1.x = pk2(v1.x, v1.y); w1.y = pk2(v1.z, v1.w);
                    const int kvh = d >> 6, db = (d >> 5) & 1, dl = d & 31, s2 = (tk0 >> 4) & 1;
                    if (u.pn < 64) {
                        GAS bf16_t* vp = Vt + (size_t)(kvh * NB32 + (tk0 >> 5)) * 2048 + 4 * a;
                        *(GAS u32x2*)(vp + vf_blk(db, s2, 0, dl)) = w0; *(GAS u32x2*)(vp + vf_blk(db, s2, 1, dl)) = w1;
                    }
                    if (u.pn < 64) {
                        if ((u.pn & 31) == 31 && bj == 1) {
                            const int b = u.pn >> 5, w = wc * 32 + 8 * fq;
                            GAS float* op = out + OFF_VP + ((size_t)(b * 128 + w)) * 256 + d;
                            op[0] = v0.x; op[256] = v0.y; op[512] = v0.z; op[768] = v0.w; op[1024] = v1.x; op[1280] = v1.y; op[1536] = v1.z; op[1792] = v1.w;
                        }
                    } else {
                        const int sq = (tk0 - TP) >> 2;
                        *(GAS u32x2*)(Vext + (size_t)((sq * 4 + kvh) * 5 + 4) * 2048 + vf_blk(db, 0, 0, dl)) = w0;
                        *(GAS u32x2*)(Vext + (size_t)(((sq + 1) * 4 + kvh) * 5 + 4) * 2048 + vf_blk(db, 0, 0, dl)) = w1;
                        GAS float* op = out + OFF_VS + ((size_t)(sq * 128 + 124)) * 256 + d;
                        op[0] = v0.x; op[256] = v0.y; op[512] = v0.z; op[768] = v0.w;
                        GAS float* op2 = op + (size_t)128 * 256;
                        op2[0] = v1.x; op2[256] = v1.y; op2[512] = v1.z; op2[768] = v1.w;
                    }
                    CFENCE();
                }
        }
    }
};
struct EpiUp {
    static constexpr bool SSQL = true;
    Bases B; int layer; LAS float* X; int dry;
    __device__ __forceinline__ const float* ssq_panel(int pm) const { return (const float*)(B.ws + WS_SSQA) + (size_t)pm * 256 * 16; }
    __device__ __forceinline__ void operator()(f32x4 (&acc)[2][2][4][2], f32x4 (&accE)[2], const Unit& u, int wr, int wc, int fr, int fq, int next_pm, unsigned ldsbase, int wid) const {
        if (dry == 1) return;
        EPI_BASES(B);
        const GAS float* ssq = (const GAS float*)(ws_ + WS_SSQA); const GAS float* ssqE = (const GAS float*)(ws_ + WS_SSQEA);
        const GAS float* cw = (const GAS float*)in_[I_CONVW] + (size_t)layer * 3 * F2; const GAS float* cb = (const GAS float*)in_[I_CONVB] + (size_t)layer * F2; const GAS float* st_in = (const GAS float*)in_[I_SCONV] + (size_t)layer * NSEQ * 2 * F2;
        GAS bf16_t* act = (GAS bf16_t*)(ws_ + WS_ACT); GAS float* uh = (GAS float*)(ws_ + WS_UH); GAS float* st_p = out_ + OFF_SCP + (size_t)layer * 2 * 2 * F2; GAS float* st_s = out_ + OFF_SCS + (size_t)layer * NSEQ * 2 * F2;
        const bool sample = u.pm >= 64;
        const int f0 = u.pn * 128 + wc * 32 + 8 * fq;
        const int rbase = u.pm * 256 + wr * 64 + 4 * fr;
        const LAS float* SSQL_ = (const LAS float*)((LAS unsigned char*)X - SCR_OFF + SSQL_OFF);
        f32x4 cwn[4];
        { const int colc0 = f0; cwn[0] = *(const GAS f32x4*)(cw + colc0); cwn[1] = *(const GAS f32x4*)(cw + F2 + colc0); cwn[2] = *(const GAS f32x4*)(cw + 2 * F2 + colc0); cwn[3] = *(const GAS f32x4*)(cb + colc0); }
        {
            f32x4 sq[8];
#pragma unroll
            for (int g = 0; g < 8; ++g) {
                const int row = rbase + (g >> 2) * 128 + (g & 3);
                if (!sample) sq[g] = *(const LAS f32x4*)(SSQL_ + (row - u.pm * 256) * 16 + 4 * fq);
                else sq[g] = *(const GAS f32x4*)(ssqE + (size_t)(row - TP) * 32 + 8 * fq) + *(const GAS f32x4*)(ssqE + (size_t)(row - TP) * 32 + 8 * fq + 4);
            }
#pragma unroll
            for (int g = 0; g < 8; ++g) {
                float q = (sq[g].x + sq[g].y) + (sq[g].z + sq[g].w); q = sum_x16(q); q = sum_x32(q);
                const float rs = rsq(q * (1.0f / 1024.0f) + EPS);
#pragma unroll
                for (int bj = 0; bj < 2; ++bj) { acc[g >> 2][bj][g & 3][0] *= rs; acc[g >> 2][bj][g & 3][1] *= rs; }
            }
            SFENCE();
        }
#define EPIUP_NEXT_SSQ() do { if (next_pm >= 0 && next_pm < 64) { const char* sp = (const char*)ssq_panel(next_pm); const unsigned tid16 = (unsigned)(wid * 64 + lane_id()) * 16u, ldsw = (unsigned)wid * 1024u; \
            glds16(sp, tid16, (unsigned)__builtin_amdgcn_readfirstlane((int)(ldsbase + (unsigned)SSQL_OFF + ldsw))); \
            glds16(sp + 8192, tid16, (unsigned)__builtin_amdgcn_readfirstlane((int)(ldsbase + (unsigned)SSQL_OFF + 8192u + ldsw))); } } while (0)
        if (dry == 2) { LDS_WAIT(); __builtin_amdgcn_s_barrier(); EPIUP_NEXT_SSQ(); return; }
        const int sq0 = (rbase - TP) >> 2;
        if (!sample) {
            if (fr == 15) {
#pragma unroll
                for (int ai = 0; ai < 2; ++ai)
#pragma unroll
                    for (int bj = 0; bj < 2; ++bj)
#pragma unroll
                        for (int k = 0; k < 2; ++k) {
                            LAS float* x = X + ((((wr * 4 + wc) * 2 + ai) * 2 + bj) * 2 + k) * 32 + fq * 8;
                            *(LAS f32x4*)x = acc[ai][bj][2 + k][0]; *(LAS f32x4*)(x + 4) = acc[ai][bj][2 + k][1];
                        }
            }
            if (wr == 0 && fr == 0) {
#pragma unroll
                for (int k = 0; k < 2; ++k)
#pragma unroll
                    for (int bj = 0; bj < 2; ++bj) { GAS float* p = uh + ((size_t)(u.pm * 4 + k)) * F2 + bj * FF + f0; *(GAS f32x4*)p = acc[0][bj][k][0]; *(GAS f32x4*)(p + 4) = acc[0][bj][k][1]; }
            }
            if (wr == 1 && fr == 15) {
#pragma unroll
                for (int k = 0; k < 2; ++k)
#pragma unroll
                    for (int bj = 0; bj < 2; ++bj) { GAS float* p = uh + ((size_t)(u.pm * 4 + 2 + k)) * F2 + bj * FF + f0; *(GAS f32x4*)p = acc[1][bj][2 + k][0]; *(GAS f32x4*)(p + 4) = acc[1][bj][2 + k][1]; }
                if ((u.pm & 31) == 31) {
#pragma unroll
                    for (int k = 0; k < 2; ++k)
#pragma unroll
                        for (int bj = 0; bj < 2; ++bj) { GAS float* p = st_p + ((size_t)((u.pm >> 5) * 2 + k)) * F2 + bj * FF + f0; *(GAS f32x4*)p = acc[1][bj][2 + k][0]; *(GAS f32x4*)(p + 4) = acc[1][bj][2 + k][1]; }
                }
            }
        } else {
#pragma unroll
            for (int ai = 0; ai < 2; ++ai)
#pragma unroll
                for (int k = 0; k < 2; ++k) {
#pragma unroll
                    for (int bj = 0; bj < 2; ++bj) { GAS float* p = st_s + ((size_t)((sq0 + 32 * ai) * 2 + k)) * F2 + bj * FF + f0; *(GAS f32x4*)p = acc[ai][bj][2 + k][0]; *(GAS f32x4*)(p + 4) = acc[ai][bj][2 + k][1]; }
                    CFENCE();
                }
        }
        LDS_WAIT(); __builtin_amdgcn_s_barrier(); SFENCE();
        EPIUP_NEXT_SSQ();
#undef EPIUP_NEXT_SSQ
        if (dry == 3) { __builtin_amdgcn_s_barrier(); return; }
#pragma unroll
        for (int bj = 0; bj < 2; ++bj)
#pragma unroll
            for (int n = 0; n < 2; ++n) {
                const int colc = bj * FF + f0 + 4 * n;
                const f32x4 w0 = cwn[0], w1 = cwn[1], w2 = cwn[2], bb = cwn[3];
                if (bj * 2 + n < 3) {
                    const int sl = bj * 2 + n + 1, cn = (sl >> 1) * FF + f0 + 4 * (sl & 1);
                    cwn[0] = *(const GAS f32x4*)(cw + cn); cwn[1] = *(const GAS f32x4*)(cw + F2 + cn); cwn[2] = *(const GAS f32x4*)(cw + 2 * F2 + cn); cwn[3] = *(const GAS f32x4*)(cb + cn);
                }
                SFENCE();
#pragma unroll
                for (int ai = 0; ai < 2; ++ai) {
                    f32x4 V2 = (f32x4){0.f, 0.f, 0.f, 0.f}, V3 = (f32x4){0.f, 0.f, 0.f, 0.f};
                    if (!sample) {
                        const bool has = !(ai == 0 && wr == 0);
                        const int swr = (ai == 0) ? 0 : (wr == 0 ? 1 : 0), sai = (ai == 1 && wr == 1) ? 1 : 0;
                        if (has && fr == 0) {
                            const LAS float* x = X + ((((swr * 4 + wc) * 2 + sai) * 2 + bj) * 2) * 32 + fq * 8 + 4 * n;
                            V2 = *(const LAS f32x4*)x; V3 = *(const LAS f32x4*)(x + 32);
                        }
                    } else {
                        const GAS float* sp = st_in + ((size_t)((sq0 + 32 * ai) * 2)) * F2 + colc;
                        V2 = *(const GAS f32x4*)sp; V3 = *(const GAS f32x4*)(sp + F2);
                    }
                    const f32x4 a0 = acc[ai][bj][0][n], a1 = acc[ai][bj][1][n], a2 = acc[ai][bj][2][n], a3 = acc[ai][bj][3][n];
                    f32x4 R2, R3;
                    if (!sample) {
                        R2.x = dpp_old<0x111>(a2.x, V2.x); R2.y = dpp_old<0x111>(a2.y, V2.y); R2.z = dpp_old<0x111>(a2.z, V2.z); R2.w = dpp_old<0x111>(a2.w, V2.w);
                        R3.x = dpp_old<0x111>(a3.x, V3.x); R3.y = dpp_old<0x111>(a3.y, V3.y); R3.z = dpp_old<0x111>(a3.z, V3.z); R3.w = dpp_old<0x111>(a3.w, V3.w);
                    } else { R2 = V2; R3 = V3; }
                    f32x4 c0 = bb + w0 * R2 + w1 * R3 + w2 * a0;
                    f32x4 c1 = bb + w0 * R3 + w1 * a0 + w2 * a1;
                    f32x4 c2 = bb + w0 * a0 + w1 * a1 + w2 * a2;
                    f32x4 c3 = bb + w0 * a1 + w1 * a2 + w2 * a3;
                    if (bj == 0) {
                        c0 = gelu_tanh4(c0); c1 = gelu_tanh4(c1); c2 = gelu_tanh4(c2); c3 = gelu_tanh4(c3);
                    }
                    acc[ai][bj][0][n] = c0; acc[ai][bj][1][n] = c1; acc[ai][bj][2][n] = c2; acc[ai][bj][3][n] = c3;
                    asm volatile("" : "+v"(acc[ai][bj][0][n]), "+v"(acc[ai][bj][1][n]), "+v"(acc[ai][bj][2][n]), "+v"(acc[ai][bj][3][n]));
                }
            }
        if (dry == 4) { __builtin_amdgcn_s_barrier(); return; }
#pragma unroll
        for (int ai = 0; ai < 2; ++ai)
#pragma unroll
            for (int m = 0; m < 4; ++m) {
                const int row = rbase + ai * 128 + m;
                const f32x4 a0 = acc[ai][0][m][0] * acc[ai][1][m][0], a1 = acc[ai][0][m][1] * acc[ai][1][m][1];
                u32x4 w; w.x = pk2(a0.x, a0.y); w.y = pk2(a0.z, a0.w); w.z = pk2(a1.x, a1.y); w.w = pk2(a1.z, a1.w);
                const bool skip = (!sample) && ai == 0 && wr == 0 && m < 2 && fr == 0;
                if (!skip) *(GAS u32x4*)(act + (size_t)row * FF + f0) = w;
                SFENCE();
            }
        __builtin_amdgcn_s_barrier();
    }
};

#define XB_TMO      128
#define XB_XCNT(j)  (256  + 64 * (j))
#define XB_XSUB(j)  (1280 + 64 * (j))
#define XB_XGEN(j)  (2304 + 64 * (j))
#define XB_TOP      3328
#define XB_TOPGEN   3392
#define XCD_BAR_WORDS 3456
#define XB_SPIN_CAP (1u << 20)
__device__ __forceinline__ unsigned xb_ld(unsigned* p)              { return __hip_atomic_load(p, __ATOMIC_RELAXED, __HIP_MEMORY_SCOPE_AGENT); }
__device__ __forceinline__ unsigned xb_add(unsigned* p, unsigned v) { return __hip_atomic_fetch_add(p, v, __ATOMIC_RELAXED, __HIP_MEMORY_SCOPE_AGENT); }
__device__ __forceinline__ unsigned xb_xcc_id() { return (unsigned)__builtin_amdgcn_s_getreg((3 << 11) | 20) & 0xFu; }
#define XB_SPIN(cond, bar) do { unsigned _sp = 0; while (cond) { __builtin_amdgcn_s_sleep(1); \
    if ((++_sp & 255u) == 0u) { if (xb_ld(&(bar)[XB_TMO])) break; if (_sp > XB_SPIN_CAP) { atomicAdd(&(bar)[XB_TMO], 1u); break; } } } } while (0)
struct XcdBarrier { unsigned* bar; unsigned x; volatile LAS unsigned* st; };
__device__ __forceinline__ XcdBarrier xcd_barrier_post(unsigned* bar, volatile LAS unsigned* st, int tid) {
    XcdBarrier b; b.bar = bar; b.x = xb_xcc_id(); b.st = st;
    if (tid == 0) (void)xb_add(&bar[XB_XCNT(b.x)], 1u);
    return b;
}
__device__ __forceinline__ void xcd_barrier_complete(unsigned* bar, unsigned x, unsigned& nloc, unsigned& nx) {
    const unsigned G = gridDim.x * gridDim.y * gridDim.z;
    unsigned sum, cnt, mine, sp = 0u;
    for (;;) {
        sum = 0u; cnt = 0u; mine = 0u;
#pragma unroll
        for (unsigned j = 0; j < 16; ++j) { const unsigned c = xb_ld(&bar[XB_XCNT(j)]); sum += c; cnt += (c > 0u) ? 1u : 0u; mine = (j == x) ? c : mine; }
        if (sum == G) break;
        __builtin_amdgcn_s_sleep(1);
        if ((++sp & 255u) == 0u) { if (xb_ld(&bar[XB_TMO])) break; if (sp > XB_SPIN_CAP) { atomicAdd(&bar[XB_TMO], 1u); break; } }
    }
    nloc = mine > 0u ? mine : 1u; nx = cnt > 0u ? cnt : 1u;
}
__device__ __forceinline__ void xcd_barrier(const XcdBarrier& b, int tid) {
    asm volatile("s_waitcnt vmcnt(0)" ::: "memory");
    __syncthreads();
    if (tid == 0) {
        unsigned* bar = b.bar;
        __builtin_amdgcn_s_waitcnt(0);
        unsigned nloc = b.st[0], nx = b.st[1];
        if (nloc == 0u) { xcd_barrier_complete(bar, b.x, nloc, nx); b.st[0] = nloc; b.st[1] = nx; }
        const unsigned old = xb_add(&bar[XB_XSUB(b.x)], 1u);
        const unsigned gen = old / nloc;
        if (old + 1u == (gen + 1u) * nloc) {
            __builtin_amdgcn_fence(__ATOMIC_RELEASE, "agent");
            asm volatile("s_waitcnt vmcnt(0)" ::: "memory");
            const unsigned og = xb_add(&bar[XB_TOP], 1u);
            const unsigned tg = og / nx, target = (tg + 1u) * nx;
            if (og + 1u != target) XB_SPIN((int)(xb_ld(&bar[XB_TOP]) - target) < 0, bar);
            (void)xb_add(&bar[XB_XGEN(b.x)], 1u);
            __builtin_amdgcn_fence(__ATOMIC_ACQUIRE, "agent");
            asm volatile("s_waitcnt vmcnt(0)" ::: "memory");
        } else {
            XB_SPIN(xb_ld(&bar[XB_XGEN(b.x)]) == gen, bar);
            __builtin_amdgcn_fence(__ATOMIC_ACQUIRE, "agent");
            asm volatile("s_waitcnt vmcnt(0)" ::: "memory");
        }
    }
    __syncthreads();
}

constexpr int MAXPROG = 48;
struct Args { const float* in[N_IN]; float* out; unsigned char* ws; int ph_lo, ph_hi, li, pad; unsigned prog[MAXPROG]; };
struct Frame {
    LAS unsigned char* lds; int wave, vcu, G;
    const float* const* in; float* out; unsigned char* ws;
};
template <class X> __device__ __forceinline__ X* wsp(const Frame& F, size_t off) { return (X*)(F.ws + off); }
__device__ __forceinline__ int ftid(const Frame& F) { return F.wave * 64 + lane_id(); }

struct WJob { const float* W; int ldw; bf16_t* WT; int ldt, k0, n0, orow0; const float* ks; const float* ns; };
struct WVals { float v[32]; float nsc; f32x4 k0v, k1v; };
__device__ __forceinline__ void job_load(const WJob& j, int lane, WVals& x) {
    const int nn = lane & 31;
    x.nsc = j.ns ? j.ns[j.n0 + nn] : 1.0f;
    const int c = lane & 7;
    x.k0v = (f32x4){1.f, 1.f, 1.f, 1.f}; x.k1v = (f32x4){1.f, 1.f, 1.f, 1.f};
    if (j.ks) { x.k0v = *(const f32x4*)(j.ks + j.k0 + 8 * c); x.k1v = *(const f32x4*)(j.ks + j.k0 + 8 * c + 4); }
#pragma unroll
    for (int i = 0; i < 32; ++i) x.v[i] = j.W[(size_t)(j.k0 + 2 * i + (lane >> 5)) * j.ldw + j.n0 + nn];
}
__device__ __forceinline__ void job_finish(const WJob& j, const WVals& x, LAS float* scr, int lane) {
    const int nn = lane & 31;
#pragma unroll
    for (int i = 0; i < 32; ++i) scr[(2 * i + (lane >> 5)) * 33 + nn] = x.v[i] * x.nsc;
    LDS_WAIT(); asm volatile("" ::: "memory");
    const int c = lane & 7;
#pragma unroll
    for (int jj = 0; jj < 4; ++jj) { const int n = (lane >> 3) + 8 * jj; const LAS float* s = scr + (8 * c) * 33 + n;
        u32x4 o; o.x = pk2(s[0 * 33] * x.k0v.x, s[1 * 33] * x.k0v.y); o.y = pk2(s[2 * 33] * x.k0v.z, s[3 * 33] * x.k0v.w); o.z = pk2(s[4 * 33] * x.k1v.x, s[5 * 33] * x.k1v.y); o.w = pk2(s[6 * 33] * x.k1v.z, s[7 * 33] * x.k1v.w);
        *(u32x4*)(j.WT + (size_t)(j.orow0 + n) * j.ldt + j.k0 + 8 * c) = o; }
    LDS_WAIT(); asm volatile("" ::: "memory");
}
__device__ __forceinline__ int map_up(int n0) { return n0 < FF ? 256 * (n0 >> 7) + (n0 & 127) : 256 * ((n0 - FF) >> 7) + 128 + ((n0 - FF) & 127); }
__device__ __forceinline__ int map_head(int n0) { const int head = n0 >> 6, bj = (n0 >> 5) & 1; return 256 * (head >> 2) + 128 * bj + 32 * (head & 3); }
__device__ __forceinline__ WJob make_job(const float* W, int K, int N, bf16_t* WT, int ldt, const float* ks, const float* ns, int maptype, int r) {
    const int nblk = N / 32, kb = r / nblk, nb = r % nblk, n0 = 32 * nb;
    const int orow0 = maptype == 1 ? map_up(n0) : (maptype == 2 ? map_head(n0) : n0);
    return WJob{W, N, WT, ldt, 64 * kb, n0, orow0, ks, ns};
}

template <bool BF> __device__ __forceinline__ f32x2 ld2(const void* src, size_t e) {
    if (BF) { const unsigned w = *(const unsigned*)((const bf16_t*)src + e); return (f32x2){bf_lo(w), bf_hi(w)}; }
    else return *(const f32x2*)((const float*)src + e);
}
template <int W, bool OUT, bool BF>
__device__ __forceinline__ void pool_block16(const void* hsrc, int b, int t0, int blk, const LAS float* rsL, float g0, float g1, int c0, float (&r0)[16], float (&r1)[16], float& S0, float& S1, bf16_t* Dq, float* st_out, const LAS unsigned char* rows) {
    f32x2 v[16];
#pragma unroll
    for (int kk = 0; kk < 16; ++kk) { const int t = t0 + blk * 16 + kk - 16;
        if (OUT) { const unsigned w = *(const LAS unsigned*)(rows + (blk * 16 + kk - 16) * 2048 + 2 * c0); v[kk] = (f32x2){bf_lo(w), bf_hi(w)}; }
        else v[kk] = ld2<BF>(hsrc, ((size_t)(b * SEQ + (t < 0 ? 0 : t))) * D + c0); }
#pragma unroll
    for (int kk = 0; kk < 16; ++kk) {
        const int k = blk * 16 + kk, t = t0 + k - 16;
        const float rs = rsL[k]; const float x0 = v[kk].x * rs * g0, x1 = v[kk].y * rs * g1;
        S0 += x0 - r0[(kk - W) & 15]; r0[kk] = x0; S1 += x1 - r1[(kk - W) & 15]; r1[kk] = x1;
        if (OUT) {
            const int cnt = (t + 1 < W) ? t + 1 : W; const float inv = 1.0f / (float)cnt;
            *(unsigned*)(Dq + ((size_t)(b * SEQ + t)) * D + c0) = pk2(S0 * inv - x0, S1 * inv - x1);
            if (t >= SEQ - 15) {
                const f32x2 xv = ld2<BF>(hsrc, ((size_t)(b * SEQ + t)) * D + c0);
                f32x2 o = {xv.x * rs * g0, xv.y * rs * g1}; *(f32x2*)(st_out + ((size_t)(b * 15 + t - (SEQ - 15))) * D + c0) = o; }
        }
    }
}
template <int W, bool BF>
__device__ __forceinline__ void pool_cols_prompt(const void* hsrc, int b, int t0, const LAS float* rsL, const float* gm, bf16_t* Dq, float* st_out, int tid, const LAS unsigned char* rows) {
    const int c0 = 2 * tid; const float g0 = gm[c0], g1 = gm[c0 + 1];
    float r0[16], r1[16];
#pragma unroll
    for (int k = 0; k < 16; ++k) { r0[k] = 0.f; r1[k] = 0.f; }
    float S0 = 0.f, S1 = 0.f;
    pool_block16<W, false, BF>(hsrc, b, t0, 0, rsL, g0, g1, c0, r0, r1, S0, S1, Dq, st_out, rows);
    for (int blk = 1; blk < 5; ++blk) pool_block16<W, true, BF>(hsrc, b, t0, blk, rsL, g0, g1, c0, r0, r1, S0, S1, Dq, st_out, rows);
}
template <int W, bool BF>
__device__ __forceinline__ void pool_cols_sample(const void* hs, const float* st_in, int sq, const LAS float* rsL, const float* gm, bf16_t* Dq, float* st_out, int tid) {
    const int c0 = 2 * tid; const float g0 = gm[c0], g1 = gm[c0 + 1];
    float r0[16], r1[16]; float S0 = 0.f, S1 = 0.f;
    r0[0] = 0.f; r1[0] = 0.f;
#pragma unroll
    for (int k = 1; k < 16; ++k) { const f32x2 v = *(const f32x2*)(st_in + ((size_t)(sq * 15 + k - 1)) * D + c0); r0[k] = v.x; r1[k] = v.y; }
#pragma unroll
    for (int k = 16 - W; k < 16; ++k) { S0 += r0[k]; S1 += r1[k]; }
#pragma unroll
    for (int k = 5; k < 16; ++k) { f32x2 o = {r0[k], r1[k]}; *(f32x2*)(st_out + ((size_t)(sq * 15 + k - 5)) * D + c0) = o; }
    const float inv = 1.0f / (float)W;
#pragma unroll
    for (int kk = 0; kk < 4; ++kk) {
        const f32x2 v = ld2<BF>(hs, ((size_t)(sq * 4 + kk)) * D + c0); const float rs = rsL[kk];
        const float x0 = v.x * rs * g0, x1 = v.y * rs * g1;
        S0 += x0 - r0[(kk - W) & 15]; r0[kk] = x0; S1 += x1 - r1[(kk - W) & 15]; r1[kk] = x1;
        *(unsigned*)(Dq + ((size_t)(TP + sq * 4 + kk)) * D + c0) = pk2(S0 * inv - x0, S1 * inv - x1);
        f32x2 o = {x0, x1}; *(f32x2*)(st_out + ((size_t)(sq * 15 + 11 + kk)) * D + c0) = o;
    }
}
template <bool BF> __device__ __forceinline__ void row_load16(const void* src, size_t rowoff, int lane, f32x4 (&v)[4]) {
    if (BF) { const u32x4* p = (const u32x4*)((const bf16_t*)src + rowoff) + lane;
#pragma unroll
        for (int j = 0; j < 2; ++j) { const u32x4 w = p[64 * j]; v[2 * j] = (f32x4){bf_lo(w.x), bf_hi(w.x), bf_lo(w.y), bf_hi(w.y)}; v[2 * j + 1] = (f32x4){bf_lo(w.z), bf_hi(w.z), bf_lo(w.w), bf_hi(w.w)}; } }
    else { const f32x4* p = (const f32x4*)((const float*)src + rowoff) + lane;
#pragma unroll
        for (int j = 0; j < 4; ++j) v[j] = p[64 * j]; }
}
__device__ __forceinline__ float ssq16(const f32x4 (&v)[4]) {
    float q = 0.f;
#pragma unroll
    for (int j = 0; j < 4; ++j) q += (v[j].x * v[j].x + v[j].y * v[j].y) + (v[j].z * v[j].z + v[j].w * v[j].w);
    return wave_sum(q);
}
template <bool BF>
__device__ __forceinline__ void poolprep_phase(const Frame& F, int layer, const void* hp, const void* hs) {
    LAS float* rsL = (LAS float*)(F.lds + SCR_OFF);
    const int tid = ftid(F), lane = tid & 63;
    const float* gm = F.in[I_NMIX] + layer * D;
    bf16_t* Dq = wsp<bf16_t>(F, WS_DQ);
    float* stp = F.out + OFF_SPP + (size_t)layer * 2 * 15 * D;
    float* sts = F.out + OFF_SPS + (size_t)layer * NSEQ * 15 * D;
    const float* st_in = F.in[I_SPOOL] + (size_t)layer * NSEQ * 15 * D;
    __syncthreads();
    for (int ci = F.vcu; ci < 256; ci += F.G) {
        const int b = ci >> 7, t0 = (ci & 127) * 64;
        {
#pragma unroll
            for (int half = 0; half < 2; ++half) {
                f32x4 v[5][4];
#pragma unroll
                for (int i = 0; i < 5; ++i) { const int k = F.wave + 8 * (5 * half + i), t = t0 - 16 + k; row_load16<BF>(hp, ((size_t)(b * SEQ + (t < 0 ? 0 : t))) * D, lane, v[i]); }
#pragma unroll
                for (int i = 0; i < 5; ++i) { const int k = F.wave + 8 * (5 * half + i), t = t0 - 16 + k; const float q = ssq16(v[i]);
                    if (lane == 0) rsL[k] = (t >= 0) ? rsq(q * (1.0f / D) + EPS) : 0.f;
                    if (k >= 16) {
                        LAS unsigned char* rr = F.lds + (k - 16) * 2048;
                        if (BF) {
#pragma unroll
                            for (int j = 0; j < 2; ++j) { u32x4 w; w.x = pk2(v[i][2 * j].x, v[i][2 * j].y); w.y = pk2(v[i][2 * j].z, v[i][2 * j].w); w.z = pk2(v[i][2 * j + 1].x, v[i][2 * j + 1].y); w.w = pk2(v[i][2 * j + 1].z, v[i][2 * j + 1].w);
                                *(LAS u32x4*)(rr + (64 * j + lane) * 16) = w; }
                        } else {
#pragma unroll
                            for (int j = 0; j < 4; ++j) { u32x2 w; w.x = pk2(v[i][j].x, v[i][j].y); w.y = pk2(v[i][j].z, v[i][j].w); *(LAS u32x2*)(rr + (64 * j + lane) * 8) = w; }
                        }
                    } }
            }
        }
        __syncthreads();
        const int g = tid >> 7;
        if (g == 0) pool_cols_prompt<2, BF>(hp, b, t0, rsL, gm, Dq, stp, tid, F.lds);
        else if (g == 1) pool_cols_prompt<4, BF>(hp, b, t0, rsL, gm, Dq, stp, tid, F.lds);
        else if (g == 2) pool_cols_prompt<8, BF>(hp, b, t0, rsL, gm, Dq, stp, tid, F.lds);
        else pool_cols_prompt<16, BF>(hp, b, t0, rsL, gm, Dq, stp, tid, F.lds);
        __syncthreads();
    }
    for (int sq = F.vcu; sq < NSEQ; sq += F.G) {
        if (F.wave < 4) { f32x4 v[4]; row_load16<BF>(hs, ((size_t)(sq * 4 + F.wave)) * D, lane, v); const float r = rsq(ssq16(v) * (1.0f / D) + EPS); if (lane == 0) rsL[F.wave] = r; }
        __syncthreads();
        const int g = tid >> 7;
        if (g == 0) pool_cols_sample<2, BF>(hs, st_in, sq, rsL, gm, Dq, sts, tid);
        else if (g == 1) pool_cols_sample<4, BF>(hs, st_in, sq, rsL, gm, Dq, sts, tid);
        else if (g == 2) pool_cols_sample<8, BF>(hs, st_in, sq, rsL, gm, Dq, sts, tid);
        else pool_cols_sample<16, BF>(hs, st_in, sq, rsL, gm, Dq, sts, tid);
        __syncthreads();
    }
}

__device__ __forceinline__ int t5_bucket(int n) {
    if (n < 16) return n;
    int l = 16 + (int)(logf((float)n / 16.0f) / 2.0794415416798357f * 16.0f);
    return l < 31 ? l : 31;
}
__device__ __forceinline__ WJob layer_job(const Frame& F, int l, int it) {
    constexpr int I_UP = 16 * 176, I_DN = 44 * 32, I_G = 16 * 32, I_PJ = 4 * 32, I_Q = 16 * 32, I_KV = 16 * 8, I_O = 16 * 32, I_PL = 4 * 8;
    int r = it;
    if (r < I_UP) return make_job(F.in[I_WUP] + (size_t)l * D * F2, D, F2, wsp<bf16_t>(F, WS_WUP) + (size_t)l * F2 * D, D, F.in[I_NFFN] + l * D, nullptr, 1, r); r -= I_UP;
    if (r < I_DN) return make_job(F.in[I_WDN] + (size_t)l * FF * D, FF, D, wsp<bf16_t>(F, WS_WDN) + (size_t)l * D * FF, FF, nullptr, nullptr, 0, r); r -= I_DN;
    if (r < I_G) return make_job(F.in[I_WG] + (size_t)l * D * D, D, D, wsp<bf16_t>(F, WS_WG) + (size_t)l * D * D, D, F.in[I_NPLE] + l * D, nullptr, 0, r); r -= I_G;
    if (r < I_PJ) return make_job(F.in[I_WPJ] + (size_t)l * PLE * D, PLE, D, wsp<bf16_t>(F, WS_WP) + (size_t)l * D * PLE, PLE, nullptr, nullptr, 0, r); r -= I_PJ;
    if (l < 2) { const int g = r / I_PL, ig = l * 4 + g; r -= g * I_PL;
        return make_job(F.in[I_WPOOL] + (size_t)ig * 65536, 256, 256, wsp<bf16_t>(F, WS_WPOOL) + (size_t)ig * 65536, 256, nullptr, F.in[I_PSCALE] + ig * 256, 0, r); }
    const int j = l - 2;
    if (r < I_Q) return make_job(F.in[I_WQ] + (size_t)j * D * D, D, D, wsp<bf16_t>(F, WS_WQK) + (size_t)(j ? 1280 : 0) * D, D, F.in[I_NMIX] + (2 + j) * D, nullptr, 2, r); r -= I_Q;
    if (r < I_O) return make_job(F.in[I_WO] + (size_t)j * D * D, D, D, wsp<bf16_t>(F, WS_WO) + (size_t)j * D * D, D, nullptr, nullptr, 0, r); r -= I_O;
    if (r < I_KV) return make_job(F.in[I_WK], D, 256, wsp<bf16_t>(F, WS_WQK) + (size_t)1024 * D, D, F.in[I_KVN], nullptr, 2, r); r -= I_KV;
    return make_job(F.in[I_WV], D, 256, wsp<bf16_t>(F, WS_WV), D, F.in[I_KVN], nullptr, 0, r);
}
__device__ __forceinline__ void convert_layer_weights(const Frame& F, int l, int wi, int nw, LAS float* scr, int lane) {
    constexpr int I_UP = 16 * 176, I_DN = 44 * 32, I_G = 16 * 32, I_PJ = 4 * 32, I_Q = 16 * 32, I_KV = 16 * 8, I_O = 16 * 32, I_PL = 4 * 8;
    const int n_common = I_UP + I_DN + I_G + I_PJ;
    const int n_items = n_common + (l < 2 ? 4 * I_PL : I_Q + I_O + (l == 2 ? 2 * I_KV : 0));
    int it = wi; if (it >= n_items) return;
    WJob A = layer_job(F, l, it), B = A; WVals xa, xb;
    job_load(A, lane, xa);
    for (;;) {
        int itn = it + nw; bool hn = itn < n_items;
        if (hn) { B = layer_job(F, l, itn); job_load(B, lane, xb); }
        job_finish(A, xa, scr, lane);
        if (!hn) break;
        it = itn; itn = it + nw; hn = itn < n_items;
        if (hn) { A = layer_job(F, l, itn); job_load(A, lane, xa); }
        job_finish(B, xb, scr, lane);
        if (!hn) break;
        it = itn;
    }
}
__device__ __forceinline__ void convert_pb(const Frame& F, int i, int wi, int nw, int lane) {
    bf16_t* pb = wsp<bf16_t>(F, WS_PB) + (size_t)i * T * PLE;
    for (int row = wi * 8; row < T; row += nw * 8) {
        const float* src = row < TP ? F.in[I_PP] + ((size_t)i * TP + row) * PLE : F.in[I_PS] + ((size_t)i * 512 + (row - TP)) * PLE;
        f32x4 v[8];
#pragma unroll
        for (int k = 0; k < 8; ++k) v[k] = *((const f32x4*)(src + (size_t)k * PLE) + lane);
#pragma unroll
        for (int k = 0; k < 8; ++k) { u32x2 o; o.x = pk2(v[k].x, v[k].y); o.y = pk2(v[k].z, v[k].w); *((u32x2*)(pb + (size_t)(row + k) * PLE) + lane) = o; }
    }
}
__device__ __forceinline__ void p0_prologue(const Frame& F, int part) {
    LAS float* scr = (LAS float*)(F.lds + F.wave * 16384);
    const int tid = ftid(F), lane = tid & 63;
    const int gw = F.vcu * NWAVES + F.wave, NGW = F.G * NWAVES;
    if (part == 0 || part == 1) convert_layer_weights(F, 0, gw, NGW, scr, lane);
    if (F.G != 256) for (int l = 1; l < 4; ++l) convert_layer_weights(F, l, gw, NGW, scr, lane);
    if (part == 0 || part == 2) { convert_pb(F, 0, gw, NGW, lane); if (F.G != 256) for (int l = 1; l < 4; ++l) convert_pb(F, l, gw, NGW, lane); }
    if (part == 0 || part == 3) { bf16_t* kx = wsp<bf16_t>(F, WS_KEXT);
      for (int r4 = gw * 4; r4 < NSEQ * 128; r4 += NGW * 4) {
          const int sq = r4 >> 7, key0 = r4 & 127;
          f32x4 kv[4], vv[4];
#pragma unroll
          for (int k = 0; k < 4; ++k) { kv[k] = *((const f32x4*)(F.in[I_CK] + (size_t)(r4 + k) * 256) + lane); vv[k] = *((const f32x4*)(F.in[I_CV] + (size_t)(r4 + k) * 256) + lane); }
#pragma unroll
          for (int k = 0; k < 4; ++k) {
              u32x2 o; o.x = pk2(kv[k].x, kv[k].y); o.y = pk2(kv[k].z, kv[k].w);
              { const int key = key0 + k, e = 4 * (lane & 15); *(u32x2*)(kx + kxf_off(sq, lane >> 4, key >> 5, key & 31, e & ~7) + (e & 7)) = o; }
              if (key0 >= 4) {
                  *((f32x4*)(F.out + OFF_KS + ((size_t)(sq * 128 + key0 + k - 4)) * 256) + lane) = kv[k];
                  *((f32x4*)(F.out + OFF_VS + ((size_t)(sq * 128 + key0 + k - 4)) * 256) + lane) = vv[k];
              }
          }
      } }
    if (part == 0 || part == 3) { bf16_t* vx = wsp<bf16_t>(F, WS_VEXT);
      for (int it = gw; it < NSEQ * 9; it += NGW) {
          const int sq = it / 9, g = it % 9;
          if (g < 8) {
              f32x4 v[16];
#pragma unroll
              for (int k = 0; k < 16; ++k) v[k] = *((const f32x4*)(F.in[I_CV] + ((size_t)(sq * 128 + 16 * g + k)) * 256) + lane);
#pragma unroll
              for (int dd = 0; dd < 4; ++dd) {
                  float e[16];
#pragma unroll
                  for (int p = 0; p < 16; ++p) { const int key = 8 * ((p >> 2) & 1) + 4 * (p >> 3) + (p & 3); e[p] = v[key][dd]; }
                  u32x4 o0, o1; o0.x = pk2(e[0], e[1]); o0.y = pk2(e[2], e[3]); o0.z = pk2(e[4], e[5]); o0.w = pk2(e[6], e[7]); o1.x = pk2(e[8], e[9]); o1.y = pk2(e[10], e[11]); o1.z = pk2(e[12], e[13]); o1.w = pk2(e[14], e[15]);
                  const int d = 4 * lane + dd, kvh = d >> 6, db = (d >> 5) & 1, dl = d & 31;
                  bf16_t* dst = vx + (size_t)((sq * 4 + kvh) * 5 + (g >> 1)) * 2048;
                  *(u32x4*)(dst + vf_blk(db, g & 1, 0, dl)) = o0; *(u32x4*)(dst + vf_blk(db, g & 1, 1, dl)) = o1;
              }
          } else {
              const u32x4 z = {0u, 0u, 0u, 0u};
#pragma unroll
              for (int kvh = 0; kvh < 4; ++kvh) { bf16_t* dst = vx + (size_t)((sq * 4 + kvh) * 5 + 4) * 2048;
#pragma unroll
                  for (int i = 0; i < 4; ++i) *((u32x4*)dst + i * 64 + lane) = z; }
          }
      } }
    { float* bt = wsp<float>(F, WS_BTAB);
      for (int i = F.vcu * 512 + tid; i < 16 * 128 + 32; i += F.G * 512) {
          if (i < 2048) { const int h = i >> 7, d = i & 127; bt[i] = F.in[I_RELB][t5_bucket(d) * 16 + h] * LOG2E; }
          else bt[i] = F.in[I_SINK][i - 2048] * LOG2E;
      } }
    if (part == 0 || part == 4) poolprep_phase<false>(F, 0, F.in[I_XP], F.in[I_XS]);
}

__device__ __forceinline__ void conv_patch(const Frame& F, int layer, int pm) {
    const float* uh = wsp<float>(F, WS_UH); bf16_t* act = wsp<bf16_t>(F, WS_ACT);
    const float* cw = F.in[I_CONVW] + (size_t)layer * 3 * F2; const float* cb = F.in[I_CONVB] + (size_t)layer * F2;
    const bool hasprev = (pm & 31) != 0;
    const float* up = uh + (size_t)((hasprev ? pm - 1 : pm) * 4) * F2;
    const float* uc = uh + (size_t)(pm * 4) * F2;
    const float pz = hasprev ? 1.0f : 0.0f;
    const int tid = ftid(F);
    float v[6][2][8];
#pragma unroll
    for (int k = 0; k < 6; ++k) {
        const int f = tid + k * NWAVES * 64; const int fc = f < FF ? f : FF - 1;
#pragma unroll
        for (int part = 0; part < 2; ++part) {
            const int col = part * FF + fc;
            v[k][part][0] = up[2 * F2 + col]; v[k][part][1] = up[3 * F2 + col]; v[k][part][2] = uc[col]; v[k][part][3] = uc[F2 + col];
            v[k][part][4] = cw[col]; v[k][part][5] = cw[F2 + col]; v[k][part][6] = cw[2 * F2 + col]; v[k][part][7] = cb[col];
        }
    }
#pragma unroll
    for (int k = 0; k < 6; ++k) {
        const int f = tid + k * NWAVES * 64;
        float c0[2], c1[2];
#pragma unroll
        for (int part = 0; part < 2; ++part) {
            const float um2 = v[k][part][0] * pz, um1 = v[k][part][1] * pz, u0 = v[k][part][2], u1 = v[k][part][3], w0 = v[k][part][4], w1 = v[k][part][5], w2 = v[k][part][6], b = v[k][part][7];
            c0[part] = b + w0 * um2 + w1 * um1 + w2 * u0; c1[part] = b + w0 * um1 + w1 * u0 + w2 * u1;
        }
        if (f < FF) {
            act[((size_t)(pm * 256)) * FF + f] = (bf16_t)(pk2(gelu_tanh(c0[0]) * c0[1], 0.f) & 0xffffu);
            act[((size_t)(pm * 256 + 1)) * FF + f] = (bf16_t)(pk2(gelu_tanh(c1[0]) * c1[1], 0.f) & 0xffffu);
        }
    }
}

__device__ __forceinline__ int crow(int r, int hi) { return (r & 3) + 8 * (r >> 2) + 4 * hi; }
template <bool SAMPLE, bool LK>
__device__ __forceinline__ void attn_wave(const Frame& F, int unit, int j, const LAS float* btab, int dry, const LAS unsigned char* klds, const LAS unsigned char* vlds) {
    const int lane = lane_id(), ql = lane & 31, hh = lane >> 5;
    const bf16_t* Q = wsp<bf16_t>(F, WS_DQ); bf16_t* O = wsp<bf16_t>(F, WS_DQ);
    int h, kvh, qrow, c0, qe; bool first; const bf16_t* Kbase; const bf16_t* Vbase;
    if (!SAMPLE) {
        const int nb = unit >> 6, rem = unit & 63, sub = rem >> 4; h = rem & 15; kvh = h >> 2;
        qrow = nb * 128 + 32 * sub + ql; c0 = sub; qe = 128 + 32 * sub + ql; first = (nb & 63) == 0;
        Kbase = wsp<bf16_t>(F, WS_KB) + ((ptrdiff_t)(kvh * NB32 + 4 * nb - 4)) * 2048;
        Vbase = wsp<bf16_t>(F, WS_VT) + ((ptrdiff_t)(kvh * NB32 + 4 * nb - 4)) * 2048;
    } else {
        const int sq = unit >> 2; kvh = unit & 3; const int g4 = (ql >> 2) & 3, t = ql & 3; h = kvh * 4 + g4;
        qrow = TP + 4 * sq + t; c0 = 0; qe = 128 + t; first = false;
        Kbase = wsp<bf16_t>(F, WS_KEXT) + (size_t)((sq * 4 + kvh) * 5) * 2048;
        Vbase = wsp<bf16_t>(F, WS_VEXT) + (size_t)((sq * 4 + kvh) * 5) * 2048;
    }
    bf16x8 qf[4];
#pragma unroll
    for (int s = 0; s < 4; ++s) qf[s] = *(const bf16x8*)(Q + (size_t)qrow * D + h * 64 + 16 * s + 8 * hh);
    bf16x8 kf[5][4];
#pragma unroll
    for (int ci = 0; ci < 5; ++ci) {
        const int c = c0 + ci, ca = (first && c < 4) ? c + 4 : c;
#pragma unroll
        for (int s = 0; s < 4; ++s) { if (LK) kf[ci][s] = *(const LAS bf16x8*)(klds + ca * 4096 + ((s * 2 + hh) * 32 + ql) * 16); else kf[ci][s] = *(const bf16x8*)(Kbase + (ptrdiff_t)ca * 2048 + ((s * 2 + hh) * 32 + ql) * 8); }
    }
    const float sink2 = btab[2048 + j * 16 + h];
    f32x16 S[5];
#pragma unroll
    for (int ci = 0; ci < 5; ++ci) {
        f32x16 a;
#pragma unroll
        for (int r = 0; r < 16; ++r) a[r] = 0.f;
#pragma unroll
        for (int s = 0; s < 4; ++s) a = __builtin_amdgcn_mfma_f32_32x32x16_bf16(kf[ci][s], qf[s], a, 0, 0, 0);
        S[ci] = a;
    }
    bf16x8 vf[5][2][2];
#pragma unroll
    for (int ci = 0; ci < 5; ++ci) {
        const int c = c0 + ci, ca = (first && c < 4) ? c + 4 : c;
#pragma unroll
        for (int s2 = 0; s2 < 2; ++s2)
#pragma unroll
            for (int db = 0; db < 2; ++db) { if (LK) vf[ci][s2][db] = *(const LAS bf16x8*)(vlds + ca * 4096 + (((db * 2 + s2) * 2 + hh) * 32 + ql) * 16); else vf[ci][s2][db] = *(const bf16x8*)(Vbase + (ptrdiff_t)ca * 2048 + (((db * 2 + s2) * 2 + hh) * 32 + ql) * 8); }
    }
    float mx = sink2;
#pragma unroll
    for (int ci = 0; ci < 5; ++ci) {
        const int c = c0 + ci;
        const bool skip = first && c < 4;
#pragma unroll
        for (int r = 0; r < 16; ++r) {
            const int key = 32 * c + crow(r, hh), d = qe - key;
            const bool valid = (!skip) && d >= 0 && d < 128;
            const int dd = d < 0 ? 0 : (d > 127 ? 127 : d);
            const float v = (S[ci][r] + btab[h * 128 + dd]) + (valid ? 0.f : -INFINITY);
            S[ci][r] = v; mx = fmaxf(mx, v);
        }
    }
    mx = max_x32(mx);
    float l = 0.f;
#pragma unroll
    for (int ci = 0; ci < 5; ++ci)
#pragma unroll
        for (int r = 0; r < 16; ++r) { const float p = __builtin_amdgcn_exp2f(S[ci][r] - mx); S[ci][r] = p; l += p; }
    l = sum_x32(l);
    const float inv = 1.0f / (l + __builtin_amdgcn_exp2f(sink2 - mx));
    f32x16 o[2];
#pragma unroll
    for (int r = 0; r < 16; ++r) { o[0][r] = 0.f; o[1][r] = 0.f; }
#pragma unroll
    for (int ci = 0; ci < 5; ++ci) {
#pragma unroll
        for (int s2 = 0; s2 < 2; ++s2) {
            u32x4 pw; pw.x = pk2(S[ci][8 * s2 + 0], S[ci][8 * s2 + 1]); pw.y = pk2(S[ci][8 * s2 + 2], S[ci][8 * s2 + 3]); pw.z = pk2(S[ci][8 * s2 + 4], S[ci][8 * s2 + 5]); pw.w = pk2(S[ci][8 * s2 + 6], S[ci][8 * s2 + 7]);
            const bf16x8 pf = __builtin_bit_cast(bf16x8, pw);
#pragma unroll
            for (int db = 0; db < 2; ++db) o[db] = __builtin_amdgcn_mfma_f32_32x32x16_bf16(vf[ci][s2][db], pf, o[db], 0, 0, 0);
        }
    }
    if ((!SAMPLE || ql < 16) && !dry) {
#pragma unroll
        for (int db = 0; db < 2; ++db)
#pragma unroll
            for (int g = 0; g < 4; ++g) {
                u32x2 w; w.x = pk2(o[db][4 * g] * inv, o[db][4 * g + 1] * inv); w.y = pk2(o[db][4 * g + 2] * inv, o[db][4 * g + 3] * inv);
                *(u32x2*)(O + (size_t)qrow * D + h * 64 + 32 * db + 8 * g + 4 * hh) = w;
            }
    }
}
__device__ __forceinline__ void attn_phase(const Frame& F, int j, int dry) {
    LAS float* btab = (LAS float*)(F.lds + SCR_OFF);
    const float* bt = wsp<float>(F, WS_BTAB);
    const int tid = ftid(F);
    for (int i = tid; i < 2048 + 32; i += NWAVES * 64) btab[i] = bt[i];
    __syncthreads();
    const LAS unsigned char* klds = F.lds; const LAS unsigned char* vlds = F.lds + 32768;
    const unsigned ldsb = (unsigned)(uintptr_t)F.lds;
    for (int bu = F.vcu; bu < 128 * 4; bu += F.G) {
        const int nb = bu >> 2, kvh = bu & 3; const bool first = (nb & 63) == 0;
        const char* kg = (const char*)(wsp<bf16_t>(F, WS_KB) + ((ptrdiff_t)(kvh * NB32 + 4 * nb - 4)) * 2048);
        const char* vg = (const char*)(wsp<bf16_t>(F, WS_VT) + ((ptrdiff_t)(kvh * NB32 + 4 * nb - 4)) * 2048);
#pragma unroll
        for (int i = 0; i < 4; ++i) {
            if (!(first && i < 2)) {
                glds16(kg + i * 8192, (unsigned)tid * 16u, (unsigned)__builtin_amdgcn_readfirstlane((int)(ldsb + i * 8192 + F.wave * 1024)));
                glds16(vg + i * 8192, (unsigned)tid * 16u, (unsigned)__builtin_amdgcn_readfirstlane((int)(ldsb + 32768 + i * 8192 + F.wave * 1024)));
            }
        }
        VM_WAIT(); __syncthreads();
#pragma unroll 1
        for (int r = 0; r < 2; ++r) {
            const int sub = F.wave & 3, h = kvh * 4 + (F.wave >> 2) * 2 + r;
            attn_wave<false, true>(F, nb * 64 + sub * 16 + h, j, btab, dry, klds, vlds);
        }
        __syncthreads();
    }
    const int gw = F.vcu * NWAVES + F.wave, NGW = F.G * NWAVES;
    for (int u = gw; u < NSEQ * 4; u += NGW) attn_wave<true, false>(F, u, j, btab, dry, klds, vlds);
}

#define PHASE_FN __device__ __forceinline__
struct PhaseCtx { const float* const* in; float* out; unsigned char* ws; int wave, vcu, G, bx, layer, kind, dry; };
__device__ __forceinline__ Frame make_frame(const PhaseCtx& c) {
    extern __shared__ __attribute__((aligned(16))) unsigned char lds[];
    Frame F; F.lds = (LAS unsigned char*)lds; F.wave = c.wave; F.vcu = c.vcu; F.G = c.G; F.in = c.in; F.out = c.out; F.ws = c.ws; return F;
}
PHASE_FN void phase_p0(PhaseCtx c) { const Frame F = make_frame(c); p0_prologue(F, c.dry); }
PHASE_FN void phase_pool(PhaseCtx c) { const Frame F = make_frame(c); const bf16_t* hb1 = wsp<bf16_t>(F, WS_HB1); poolprep_phase<true>(F, c.layer, hb1, hb1 + (size_t)TP * D); }
PHASE_FN void phase_res(PhaseCtx c) {
    const Frame F = make_frame(c); const int layer = c.layer, kind = c.kind, bx = c.bx;
    LAS unsigned char* ebuf = F.lds + SCR_OFF + 8192;
    pg8::Gemm g;
    const Bases BS{F.in, F.out, F.ws};
    EpiRes E; E.B = BS; E.src = (kind == 1) ? 2 : ((kind == 0 && layer == 0) ? 0 : 1); E.dry = c.dry;
    if (kind == 0) { bf16_t* dq = wsp<bf16_t>(F, WS_DQ); g = pg8::Gemm{dq, wsp<bf16_t>(F, WS_WPOOL) + (size_t)layer * D * 256, D, 256, 256, 256, dq + (size_t)TP * D}; }
    else if (kind == 1) { bf16_t* act = wsp<bf16_t>(F, WS_ACT); g = pg8::Gemm{act, wsp<bf16_t>(F, WS_WDN) + (size_t)layer * D * FF, FF, FF, FF, 0, act + (size_t)TP * FF};
        { pg8::StaticOrder S; S.init(TP, D, F.G, bx); pg8::Unit u; for (int i = 0; S.next(i, u); ++i) conv_patch(F, layer, u.pm); }
        VM_WAIT(); __syncthreads(); }
    else { bf16_t* dq = wsp<bf16_t>(F, WS_DQ); g = pg8::Gemm{dq, wsp<bf16_t>(F, WS_WO) + (size_t)(layer - 2) * D * D, D, D, D, 0, dq + (size_t)TP * D}; }
    pg8::gemm_phase<EpiRes, true>(F.lds, ebuf, ftid(F), g, TP, D, F.G, bx, E);
}
PHASE_FN void phase_pp(PhaseCtx c, int G_, int c_) {
    const Frame F = make_frame(c); const int layer = c.layer;
    LAS unsigned char* ebuf = F.lds + SCR_OFF + 8192;
    const bf16_t* pb = wsp<bf16_t>(F, WS_PB) + (size_t)layer * T * PLE;
    const pg8::Gemm g2{pb, wsp<bf16_t>(F, WS_WP) + (size_t)layer * D * PLE, PLE, PLE, PLE, 0, pb + (size_t)TP * PLE};
    const EpiBf16 E2{Bases{F.in, F.out, F.ws}};
    pg8::gemm_phase<EpiBf16, true>(F.lds, ebuf, ftid(F), g2, TP, D, G_, c_, E2);
}
PHASE_FN void phase_up(PhaseCtx c) {
    const Frame F = make_frame(c); const int layer = c.layer;
    bf16_t* hb0 = wsp<bf16_t>(F, WS_HB0);
    const pg8::Gemm g{hb0, wsp<bf16_t>(F, WS_WUP) + (size_t)layer * F2 * D, D, D, D, 0, hb0};
    EpiUp E; E.B = Bases{F.in, F.out, F.ws}; E.layer = layer; E.X = (LAS float*)(F.lds + SCR_OFF); E.dry = c.dry;
    pg8::gemm_phase<EpiUp, false, true>(F.lds, F.lds + SCR_OFF + 8192, ftid(F), g, T, F2, F.G, c.bx, E);
    const int n6 = (T / 256) * (F2 / 256) - 5 * F.G;
    if (layer < 3 && !c.dry && F.G == 256 && c.bx >= n6) {
        const int lane = lane_id();
        int z_ = 0; asm volatile("" : "+s"(z_));
        Frame F2 = F; F2.in = F.in + z_; F2.ws = F.ws + z_; F2.out = F.out + z_;
        convert_layer_weights(F2, layer + 1 + z_, (c.bx - n6) * NWAVES + F.wave, (F.G - n6) * NWAVES, (LAS float*)(F.lds + F.wave * 16384), lane);
        convert_pb(F2, layer + 1 + z_, (c.bx - n6) * NWAVES + F.wave, (F.G - n6) * NWAVES, lane);
    }
}
PHASE_FN void phase_ple(PhaseCtx c) {
    const Frame F = make_frame(c); const int layer = c.layer;
    bf16_t* hb0 = wsp<bf16_t>(F, WS_HB0);
    const pg8::Gemm g{hb0, wsp<bf16_t>(F, WS_WG) + (size_t)layer * D * D, D, D, D, 0, hb0 + (size_t)TP * D};
    const EpiPle E{Bases{F.in, F.out, F.ws}, (layer == 1 || layer == 2) ? 1 : 0, (layer == 3) ? 1 : 0, c.dry};
    pg8::gemm_phase<EpiPle, true>(F.lds, F.lds + SCR_OFF + 8192, ftid(F), g, TP, D, F.G, c.bx, E);
}
PHASE_FN void phase_q(PhaseCtx c) {
    const Frame F = make_frame(c); const int jq = c.layer - 2;
    bf16_t* hb1 = wsp<bf16_t>(F, WS_HB1);
    const pg8::Gemm g{hb1, wsp<bf16_t>(F, WS_WQK) + (size_t)(jq ? 1280 : 0) * D, D, D, D, 0, hb1 + (size_t)TP * D};
    const EpiQ E{Bases{F.in, F.out, F.ws}, jq, (LAS float*)(F.lds + SCR_OFF + 12288)};
    pg8::gemm_phase<EpiQ, true>(F.lds, F.lds + SCR_OFF + 8192, ftid(F), g, TP, D, F.G, c.bx, E);
}
PHASE_FN void phase_k(PhaseCtx c) {
    const Frame F = make_frame(c);
    bf16_t* hb1 = wsp<bf16_t>(F, WS_HB1);
    const pg8::Gemm g{hb1, wsp<bf16_t>(F, WS_WQK) + (size_t)1024 * D, D, D, D, 0, hb1};
    const EpiK E{Bases{F.in, F.out, F.ws}};
    pg8::gemm_phase<EpiK, false>(F.lds, F.lds + SCR_OFF + 8192, ftid(F), g, T, 256, F.G, c.bx, E);
}
PHASE_FN void phase_vt(PhaseCtx c) {
    const Frame F = make_frame(c);
    bf16_t* hb1 = wsp<bf16_t>(F, WS_HB1);
    const pg8::Gemm g2{wsp<bf16_t>(F, WS_WV), hb1, D, D, D, 0, hb1};
    const EpiVt E2{Bases{F.in, F.out, F.ws}};
    pg8::gemm_phase<EpiVt, false>(F.lds, F.lds + SCR_OFF + 8192, ftid(F), g2, 256, T, F.G, c.bx - 66, E2);
}
PHASE_FN void phase_attn(PhaseCtx c) { const Frame F = make_frame(c); attn_phase(F, c.layer - 2, c.dry); }

__global__ void __launch_bounds__(NWAVES * 64, 2) yoco_fwd(Args args) {
    extern __shared__ __attribute__((aligned(16))) unsigned char lds[];
    LAS unsigned char* ldsp = (LAS unsigned char*)lds;
    const int wave_s = __builtin_amdgcn_readfirstlane((int)threadIdx.x >> 6);
    PhaseCtx c; c.in = args.in; c.out = args.out; c.ws = args.ws; c.wave = wave_s; c.G = gridDim.x; c.bx = (int)blockIdx.x;
    { const int bx = blockIdx.x; c.vcu = (c.G % 8 == 0) ? (bx % 8) * (c.G / 8) + bx / 8 : bx; }
    volatile LAS unsigned* MISC = (volatile LAS unsigned*)(ldsp + MISC_OFF);
    for (int u = wave_s * 64 + lane_id(); u < (SCR_OFF - RING_BYTES) / 4; u += NWAVES * 64) ((LAS unsigned*)(ldsp + RING_BYTES))[u] = 0u;
    __syncthreads();
    unsigned* ctl = (unsigned*)(args.ws + WS_CTL);
    XcdBarrier bar; bar.bar = ctl + CW_BAR; bar.x = 0; bar.st = nullptr;
    const bool use_bar = (args.ph_hi - args.ph_lo) > 1;
    if (use_bar) bar = xcd_barrier_post(ctl + CW_BAR, MISC + 8, wave_s * 64 + lane_id());
    for (int ph = args.ph_lo; ph < args.ph_hi; ++ph) {
        const unsigned pe = (unsigned)__builtin_amdgcn_readfirstlane((int)args.prog[ph]);
        const int type = (int)(pe & 15u);
        c.layer = (int)((pe >> 4) & 15u); c.kind = (int)((pe >> 8) & 15u); c.dry = (int)((pe >> 12) & 7u);
        if (type == 0) phase_p0(c);
        else if (type == 4) phase_pool(c);
        else if (type == 1) phase_res(c);
        else if (type == 2) phase_up(c);
        else if (type == 3) phase_ple(c);
        else if (type == 5) { phase_q(c); if (c.layer == 2) { phase_k(c); phase_vt(c); } }
        else if (type == 6) phase_attn(c);
        { int ppg = 0, ppc = 0;
          if (type == 1 && c.kind == 1 && (c.layer < 2 || c.G != 256)) { ppg = c.G; ppc = c.bx; }
          else if (c.G == 256 && type == 5 && c.layer == 2) { ppg = 120; ppc = c.bx - 136; }
          else if (c.G == 256 && type == 2 && c.layer == 3) { ppg = 80; ppc = c.bx - 176; }
          if (ppg) phase_pp(c, ppg, ppc); }
        if (ph + 1 < args.ph_hi) xcd_barrier(bar, wave_s * 64 + lane_id());
    }
}

extern "C" void kernel_launch(void* const* d_in, const int* in_sizes, int n_in, void* d_out, int out_size, void* d_ws, size_t ws_size, hipStream_t stream) {
    static int grid = 0;
    if (grid == 0) {
        if (n_in != N_IN || (size_t)out_size != OUT_TOTAL || ws_size < WS_END) { fprintf(stderr, "kernel_launch: unexpected shapes: n_in %d out %d ws %zu (need %zu); nothing launched\n", n_in, out_size, ws_size, (size_t)WS_END); grid = -1; return; }
        int dev = 0, cus = 0, per_cu = 0;
        if (hipGetDevice(&dev) != hipSuccess || hipDeviceGetAttribute(&cus, hipDeviceAttributeMultiprocessorCount, dev) != hipSuccess) { fprintf(stderr, "kernel_launch: device query failed\n"); grid = -1; return; }
        if (hipFuncSetAttribute((const void*)yoco_fwd, hipFuncAttributeMaxDynamicSharedMemorySize, LDS_BYTES) != hipSuccess) { fprintf(stderr, "kernel_launch: hipFuncSetAttribute failed\n"); grid = -1; return; }
        if (hipOccupancyMaxActiveBlocksPerMultiprocessor(&per_cu, (const void*)yoco_fwd, NWAVES * 64, LDS_BYTES) != hipSuccess || per_cu < 1) fprintf(stderr, "kernel_launch: occupancy query reports %d blocks per CU\n", per_cu);
        (void)hipGetLastError();
        grid = cus;
    }
    if (grid < 0) return;
    if (hipMemsetAsync((char*)d_ws + WS_CTL, 0, CTL_ZERO_BYTES, stream) != hipSuccess) { fprintf(stderr, "kernel_launch: memset failed\n"); return; }
    Args a{};
    for (int i = 0; i < N_IN; ++i) a.in[i] = (const float*)d_in[i];
    a.out = (float*)d_out; a.ws = (unsigned char*)d_ws;
    int np = 0;
    auto add = [&](int type, int layer, int kind) {
#if PROBE_REP_TYPE >= 0
        if (type == PROBE_REP_TYPE) for (int r = 0; r < PROBE_REPS; ++r) a.prog[np++] = (unsigned)(type | layer << 4 | kind << 8 | PROBE_DRY << 12);
#endif
        a.prog[np++] = (unsigned)(type | layer << 4 | kind << 8);
#if PROBE_REP_TYPE == 7
        for (int r = 0; r < PROBE_REPS; ++r) a.prog[np++] = 7u;
#endif
    };
    add(0, 0, 0);
    for (int l = 0; l < 4; ++l) {
        if (l == 1) add(4, 1, 0);
        if (l < 2) add(1, l, 0); else { add(5, l, 0); add(6, l, 0); add(1, l, 2); }
        add(2, l, 0); add(1, l, 1); add(3, l, 0);
    }
#if MK_N_LAUNCHES == 1
    a.ph_lo = 0; a.ph_hi = np; a.li = 0;
    hipLaunchKernelGGL(yoco_fwd, dim3(grid), dim3(NWAVES * 64), LDS_BYTES, stream, a);
#else
    for (int p = 0; p < np; ++p) { a.ph_lo = p; a.ph_hi = p + 1; a.li = p; hipLaunchKernelGGL(yoco_fwd, dim3(grid), dim3(NWAVES * 64), LDS_BYTES, stream, a); }
#endif
    const hipError_t le = hipPeekAtLastError();
    if (le != hipSuccess) fprintf(stderr, "kernel_launch: launch failed: %s\n", hipGetErrorName(le));
}
```

```cpp
#include <hip/hip_runtime.h>
#include <cstdio>
#include <cstdint>

#ifndef MK_N_LAUNCHES
#define MK_N_LAUNCHES 1
#endif
#ifndef PROBE_REP_TYPE
#define PROBE_REP_TYPE -1
#endif
#ifndef PROBE_REPS
#define PROBE_REPS 0
#endif
#ifndef PROBE_DRY
#define PROBE_DRY 1
#endif

#define LAS __attribute__((address_space(3)))
#define GAS __attribute__((address_space(1)))
typedef unsigned short bf16_t;
typedef short bf16x8 __attribute__((ext_vector_type(8)));
typedef float f32x4 __attribute__((ext_vector_type(4)));
typedef float f32x2 __attribute__((ext_vector_type(2)));
typedef float f32x16 __attribute__((ext_vector_type(16)));
typedef unsigned u32x4 __attribute__((ext_vector_type(4)));
typedef unsigned u32x2 __attribute__((ext_vector_type(2)));
typedef __bf16 bf16x2_t __attribute__((ext_vector_type(2)));

constexpr int T = 16896, TP = 16384, D = 1024, FF = 2816, F2 = 5632, PLE = 256, SEQ = 8192, NSEQ = 128;
constexpr float EPS = 1e-6f;
constexpr float LOG2E = 1.4426950408889634f;
constexpr float QSCALE = 0.125f * LOG2E;
enum { I_XP = 0, I_XS, I_PP, I_PS, I_SPOOL, I_SCONV, I_CK, I_CV, I_NMIX, I_NFFN, I_NPLE, I_WPOOL, I_PSCALE, I_KVN, I_WK, I_WV, I_KN, I_WQ, I_QN, I_SINK, I_WO, I_RELB, I_WUP, I_CONVW, I_CONVB, I_WDN, I_WG, I_WPJ, N_IN };
constexpr size_t OFF_Y = 0, OFF_SPP = 17301504, OFF_SPS = 17362944, OFF_SCP = 21295104, OFF_SCS = 21385216, OFF_KP = 27152384, OFF_KS = 27217920, OFF_VP = 31412224, OFF_VS = 31477760, OUT_TOTAL = 35672064;
constexpr size_t MiB = 1u << 20;
constexpr size_t WS_CTL = 0, CTL_ZERO_BYTES = 32768;
constexpr size_t WS_BTAB = 1 * MiB;
constexpr size_t WS_WUP = 2 * MiB, WS_WDN = 46 * MiB, WS_WG = 68 * MiB, WS_WP = 76 * MiB, WS_WQK = 78 * MiB, WS_WV = 83 * MiB, WS_WO = 84 * MiB, WS_WPOOL = 88 * MiB;
constexpr size_t WS_PB = 89 * MiB, WS_PPJ = 122 * MiB, WS_HB0 = 155 * MiB, WS_SSQA = 188 * MiB, WS_SSQB = 190 * MiB, WS_SSQEA = WS_SSQA + 3 * MiB / 2, WS_SSQEB = WS_SSQB + 3 * MiB / 2;
constexpr size_t WS_ACT = 192 * MiB, WS_DQ = WS_ACT, WS_HB1 = WS_ACT + 33 * MiB;
constexpr size_t WS_KB = 283 * MiB, WS_VT = 292 * MiB, WS_KEXT = 301 * MiB, WS_VEXT = 311 * MiB, WS_UH = 321 * MiB, WS_PPJ3 = 327 * MiB, WS_END = 360 * MiB;
constexpr int KEXT_ROWS = 160;
constexpr int NB32 = T / 32;
__device__ __forceinline__ size_t kf_off(int kvh, int blk, int key, int e0) { return ((size_t)(kvh * NB32 + blk) * 2048) + (((e0 >> 4) * 2 + ((e0 >> 3) & 1)) * 32 + key) * 8; }
__device__ __forceinline__ size_t kxf_off(int sq, int kvh, int blk, int key, int e0) { return ((size_t)((sq * 4 + kvh) * 5 + blk) * 2048) + (((e0 >> 4) * 2 + ((e0 >> 3) & 1)) * 32 + key) * 8; }
__device__ __forceinline__ size_t vf_blk(int db, int s2, int hh, int dl) { return (size_t)((((db * 2 + s2) * 2 + hh) * 32 + dl) * 8); }
constexpr int CW_BAR = 4096;
constexpr int RING_BYTES = 131072, MISC_OFF = RING_BYTES + 320, SCR_OFF = RING_BYTES + 512, LDS_BYTES = 163840;
constexpr int SSQL_OFF = SCR_OFF + 13312;
static_assert(SSQL_OFF + 16384 <= LDS_BYTES, "LDS map");
constexpr int NWAVES = 8;
constexpr int NPHASES = 22;

__device__ __forceinline__ unsigned pk2(float lo, float hi) { f32x2 v = {lo, hi}; bf16x2_t b = __builtin_convertvector(v, bf16x2_t); return __builtin_bit_cast(unsigned, b); }
__device__ __forceinline__ float bf_lo(unsigned w) { return __builtin_bit_cast(float, w << 16); }
__device__ __forceinline__ float bf_hi(unsigned w) { return __builtin_bit_cast(float, w & 0xffff0000u); }
template <int CTRL> __device__ __forceinline__ float dppm(float x) { return __builtin_bit_cast(float, __builtin_amdgcn_update_dpp(0, __builtin_bit_cast(int, x), CTRL, 0xf, 0xf, false)); }
__device__ __forceinline__ float xor16_other(float x) { auto r = __builtin_amdgcn_permlane16_swap(__builtin_bit_cast(unsigned, x), __builtin_bit_cast(unsigned, x), false, false); const float a = __builtin_bit_cast(float, (unsigned)r[0]), b = __builtin_bit_cast(float, (unsigned)r[1]); return a + b - x; }
__device__ __forceinline__ float sum_x16(float x) { auto r = __builtin_amdgcn_permlane16_swap(__builtin_bit_cast(unsigned, x), __builtin_bit_cast(unsigned, x), false, false); return __builtin_bit_cast(float, (unsigned)r[0]) + __builtin_bit_cast(float, (unsigned)r[1]); }
__device__ __forceinline__ float sum_x32(float x) { auto r = __builtin_amdgcn_permlane32_swap(__builtin_bit_cast(unsigned, x), __builtin_bit_cast(unsigned, x), false, false); return __builtin_bit_cast(float, (unsigned)r[0]) + __builtin_bit_cast(float, (unsigned)r[1]); }
__device__ __forceinline__ float max_x32(float x) { auto r = __builtin_amdgcn_permlane32_swap(__builtin_bit_cast(unsigned, x), __builtin_bit_cast(unsigned, x), false, false); return fmaxf(__builtin_bit_cast(float, (unsigned)r[0]), __builtin_bit_cast(float, (unsigned)r[1])); }
__device__ __forceinline__ float row16_sum(float v) {
    v += dppm<0xB1>(v); v += dppm<0x4E>(v); v += dppm<0x141>(v); v += dppm<0x128>(v); return v;
}
__device__ __forceinline__ float wave_sum(float v) { v = row16_sum(v); v = sum_x16(v); v = sum_x32(v); return v; }
template <int CTRL> __device__ __forceinline__ float dppz(float x) { return __builtin_bit_cast(float, __builtin_amdgcn_update_dpp(0, __builtin_bit_cast(int, x), CTRL, 0xf, 0xf, true)); }
template <int SHR, int SHL> __device__ __forceinline__ float dpp2(float cur, float prev) {
    const int o = __builtin_amdgcn_update_dpp(0, __builtin_bit_cast(int, prev), SHL, 0xf, 0xf, true);
    return __builtin_bit_cast(float, __builtin_amdgcn_update_dpp(o, __builtin_bit_cast(int, cur), SHR, 0xf, 0xf, false));
}
template <int CTRL> __device__ __forceinline__ float dpp_old(float x, float old) { return __builtin_bit_cast(float, __builtin_amdgcn_update_dpp(__builtin_bit_cast(int, old), __builtin_bit_cast(int, x), CTRL, 0xf, 0xf, false)); }
__device__ __forceinline__ float rsq(float x) { return __builtin_amdgcn_rsqf(x); }
__device__ __forceinline__ float row_rstd(const float* ssq, int row) {
    const f32x4* p = (const f32x4*)(ssq + (size_t)row * 16);
    const f32x4 a = p[0], b = p[1], c = p[2], d = p[3];
    const float s = ((a.x + a.y) + (a.z + a.w)) + ((b.x + b.y) + (b.z + b.w)) + ((c.x + c.y) + (c.z + c.w)) + ((d.x + d.y) + (d.z + d.w));
    return rsq(s * (1.0f / 1024.0f) + EPS);
}
__device__ __forceinline__ float row_rstd4(const float* ssq, int row, int fq) {
    const f32x4 a = *(const f32x4*)(ssq + (size_t)row * 16 + 4 * fq);
    float s = (a.x + a.y) + (a.z + a.w);
    s = sum_x16(s); s = sum_x32(s);
    return rsq(s * (1.0f / 1024.0f) + EPS);
}
__device__ __forceinline__ float rstdE(const GAS float* ssqE, int sr, int fq) {
    const f32x4 a = *(const GAS f32x4*)(ssqE + (size_t)sr * 32 + 8 * fq), b = *(const GAS f32x4*)(ssqE + (size_t)sr * 32 + 8 * fq + 4);
    float s = ((a.x + a.y) + (a.z + a.w)) + ((b.x + b.y) + (b.z + b.w));
    s = sum_x16(s); s = sum_x32(s);
    return rsq(s * (1.0f / 1024.0f) + EPS);
}
#define CFENCE() asm volatile("" ::: "memory")
#define SFENCE() do { asm volatile("" ::: "memory"); __builtin_amdgcn_sched_barrier(0); } while (0)
__device__ __forceinline__ float gelu_tanh(float x) {
    const float inner = x * (1.0f + 0.044715f * x * x);
    const float t = __builtin_amdgcn_exp2f(-2.3022082f * inner);
    return x * __builtin_amdgcn_rcpf(1.0f + t);
}
__device__ __forceinline__ f32x2 gelu_tanh2(f32x2 x) {
    const f32x2 inner = x * (x * x * 0.044715f + 1.0f);
    const f32x2 z = inner * (-2.3022082f);
    f32x2 t; t.x = __builtin_amdgcn_exp2f(z.x); t.y = __builtin_amdgcn_exp2f(z.y);
    const f32x2 d = t + 1.0f;
    f32x2 r; r.x = __builtin_amdgcn_rcpf(d.x); r.y = __builtin_amdgcn_rcpf(d.y);
    return x * r;
}
__device__ __forceinline__ f32x4 gelu_tanh4(f32x4 v) { const f32x2 a = gelu_tanh2((f32x2){v.x, v.y}), b = gelu_tanh2((f32x2){v.z, v.w}); return (f32x4){a.x, a.y, b.x, b.y}; }
__device__ __forceinline__ float sigmoidf_(float x) { return __builtin_amdgcn_rcpf(1.0f + __builtin_amdgcn_exp2f(-LOG2E * x)); }
__device__ __forceinline__ int lane_id() { int l; asm volatile("v_mbcnt_lo_u32_b32 %0, -1, 0\n\tv_mbcnt_hi_u32_b32 %0, -1, %0" : "=v"(l)); return l; }
#define LDS_WAIT() asm volatile("s_waitcnt lgkmcnt(0)" ::: "memory")
#define VM_WAIT() asm volatile("s_waitcnt vmcnt(0)" ::: "memory")

__device__ __forceinline__ unsigned long long uni64(const char* p) {
    const unsigned long long v = (unsigned long long)p;
    return ((unsigned long long)(unsigned)__builtin_amdgcn_readfirstlane((int)(v >> 32)) << 32) | (unsigned)__builtin_amdgcn_readfirstlane((int)v);
}
__device__ __forceinline__ void glds16(const char* sbase_, unsigned voff, unsigned ldsdst) {
    unsigned keep; const unsigned long long sbase = uni64(sbase_);
    asm volatile("s_nop 4\n\ts_mov_b32 %0, m0\n\ts_mov_b32 m0, %3\n\ts_nop 0\n\tglobal_load_lds_dwordx4 %2, %1\n\ts_mov_b32 m0, %0" : "=&s"(keep) : "s"(sbase), "v"(voff), "s"(ldsdst) : "memory");
}
__device__ __forceinline__ void glds4(const char* sbase_, unsigned voff, unsigned ldsdst) {
    unsigned keep; const unsigned long long sbase = uni64(sbase_);
    asm volatile("s_nop 4\n\ts_mov_b32 %0, m0\n\ts_mov_b32 m0, %3\n\ts_nop 0\n\tglobal_load_lds_dword %2, %1\n\ts_mov_b32 m0, %0" : "=&s"(keep) : "s"(sbase), "v"(voff), "s"(ldsdst) : "memory");
}
namespace pg8 {
constexpr int BM = 256, BK = 64, HALF = 128, HTB = HALF * BK * 2, STAGE_BYTES = 8 * HTB, NXCD = 8, WGM = 8;
__host__ __device__ __forceinline__ int lds_byte(int r, int c) { const int st = (r >> 4) * 2 + (c >> 5), rr = r & 15, cc = c & 31, ob = rr * 64 + cc * 2; return st * 1024 + (ob ^ (((ob >> 9) & 1) << 5)); }
__host__ __device__ __forceinline__ void stage_rc(int b, int& R, int& C) { const int st = b / 1024, sb = b % 1024, swz = sb ^ (((sb >> 9) & 1) << 5); R = (st >> 1) * 16 + swz / 64; C = (st & 1) * 32 + (swz % 64) / 2; }
__host__ __device__ __forceinline__ int perm32(int rho) { const int n = rho >> 4, i = rho & 15; return 8 * (i >> 2) + 4 * n + (i & 3); }

struct Unit { int pm, pn; };
struct Gemm { const bf16_t* A; const bf16_t* Bt; int lda, ldb, K, a_pn; const bf16_t* AE; };

struct StaticOrder {
    int nM, nN, nwg, G, c, mode, lim;
    __device__ __forceinline__ void init(int M, int N, int G_, int c_) { nM = M / BM; nN = N / BM; nwg = nM * nN; G = G_; c = c_; mode = 0; lim = nwg; }
    __device__ __forceinline__ void init_up(int c_, int part) { nM = 64; nN = 22; nwg = 64 * 22; G = 256; c = c_; mode = part; lim = nwg; }
    __device__ __forceinline__ bool next(int i, Unit& u) const {
        int L;
        if (mode == 0) { L = __builtin_amdgcn_readfirstlane(i * G + c); if (L < 0 || L >= lim) return false; }
        else if (mode == 2) { if (i != 0 || c < 212) return false; const int s_ = __builtin_amdgcn_readfirstlane(c - 212); u.pm = 64 + s_ / 22; u.pn = s_ % 22; return true; }
        else {
            if (i < 4) L = i * 256 + c;
            else if (i == 4 && c < 212) L = 1024 + c;
            else if (i == 5 && c < 172) L = 1236 + c;
            else return false;
            L = __builtin_amdgcn_readfirstlane(L);
        }
        int wgid = L; { const int q = nwg / NXCD, r = nwg % NXCD, xcd = wgid % NXCD, off = wgid / NXCD; wgid = (xcd < r ? xcd * (q + 1) : r * (q + 1) + (xcd - r) * q) + off; }
        const int nig = WGM * nN, gid = wgid / nig, fm = gid * WGM, gsz = (nM - fm) < WGM ? (nM - fm) : WGM;
        u.pm = __builtin_amdgcn_readfirstlane(fm + ((wgid % nig) % gsz)); u.pn = __builtin_amdgcn_readfirstlane((wgid % nig) / gsz); return true;
    }
};

template <class Epi, bool ER, bool PA = false, int UPPART = 0>
__device__ __forceinline__ void gemm_phase(LAS unsigned char* lds, LAS unsigned char* ebuf, const int tid, const Gemm g, const int M_, const int N_, const int G_, const int c_, const Epi& E, const int lim_ = 0x7fffffff) {
    StaticOrder S; S.init(M_, N_, G_, c_); if (lim_ < S.lim) S.lim = lim_;
    if constexpr (UPPART != 0) S.init_up(c_, UPPART);
    const int wid = __builtin_amdgcn_readfirstlane(tid >> 6), lane = tid & 63, wr = wid >> 2, wc = wid & 3, fr = lane & 15, fq = lane >> 4;
    const int K = g.K, nt = K / BK;
    unsigned voffA, voffB;
    { int R, C; stage_rc(tid * 16, R, C); const int Rb = (R & ~31) + perm32(R & 31); const int Ra = PA ? (R & ~63) + 4 * (R & 15) + ((R >> 4) & 3) : R; voffA = (unsigned)(Ra * g.lda + C) * 2u; voffB = (unsigned)(Rb * g.ldb + C) * 2u; }
    const unsigned dvoffA = (unsigned)(64 * g.lda * 2), dvoffB = (unsigned)(64 * g.ldb * 2);
    const unsigned voffE = (unsigned)((tid >> 5) * g.lda) * 2u + (unsigned)(tid & 31) * 4u;
    const size_t kstep = (size_t)(BK * 2);
    const size_t hstepA = (size_t)HALF * g.lda * 2, hstepB = (size_t)HALF * g.ldb * 2;
    const size_t tstepA = 2 * hstepA, tstepB = 2 * hstepB;
    const size_t estep = (size_t)8 * g.lda * 2;
    const unsigned ldsw = (unsigned)wid * 1024u;
    const unsigned ldsbase = (unsigned)(uintptr_t)lds, ebase = (unsigned)(uintptr_t)ebuf;
#define PG8_SA(b, h) (((b) * 2 + (h)) * HTB)
#define PG8_SB(b, h) ((4 + (b) * 2 + (h)) * HTB)
#define PG8_STAGE(bufoff, gbase, voff) do { \
        glds16((const char*)(gbase), voff, (unsigned)__builtin_amdgcn_readfirstlane((int)(ldsbase + (unsigned)(bufoff) + ldsw))); \
        glds16((const char*)(gbase) + d##voff, voff, (unsigned)__builtin_amdgcn_readfirstlane((int)(ldsbase + (unsigned)(bufoff) + ldsw + 8192u))); } while (0)
#define PG8_ESTAGE(b, gbase) do { if constexpr (ER) glds4((const char*)(gbase), voffE, (unsigned)__builtin_amdgcn_readfirstlane((int)(ebase + (unsigned)((b) * 2048) + (unsigned)wid * 256u))); } while (0)
#define PG8_LDA(dst, b, h) do { _Pragma("unroll") for (int m = 0; m < 4; ++m) _Pragma("unroll") for (int k = 0; k < 2; ++k) dst[m][k] = *(const LAS bf16x8*)(lds + PG8_SA(b, h) + aoff + m * 2048 + k * 1024); } while (0)
#define PG8_LDB(dst, b, h) do { _Pragma("unroll") for (int n = 0; n < 2; ++n) _Pragma("unroll") for (int k = 0; k < 2; ++k) dst[n][k] = *(const LAS bf16x8*)(lds + PG8_SB(b, 0) + ((h) ? boff1 : boff0) + n * 2048 + k * 1024); } while (0)
#define PG8_LDE(b) do { if constexpr (ER) { Et[0] = *(const LAS bf16x8*)(ebuf + (b) * 2048 + eoff); Et[1] = *(const LAS bf16x8*)(ebuf + (b) * 2048 + eoff + 64); } } while (0)
#define PG8_MMA(ai, bj, At, Bt) do { __builtin_amdgcn_s_setprio(1); _Pragma("unroll") for (int m = 0; m < 4; ++m) _Pragma("unroll") for (int n = 0; n < 2; ++n) _Pragma("unroll") for (int k = 0; k < 2; ++k) \
        acc[ai][bj][m][n] = __builtin_amdgcn_mfma_f32_16x16x32_bf16(Bt[n][k], At[m][k], acc[ai][bj][m][n], 0, 0, 0); __builtin_amdgcn_s_setprio(0); } while (0)
#define PG8_EMMA() do { if constexpr (ER) { _Pragma("unroll") for (int n = 0; n < 2; ++n) _Pragma("unroll") for (int k = 0; k < 2; ++k) accE[n] = __builtin_amdgcn_mfma_f32_16x16x32_bf16(B0[n][k], Et[k], accE[n], 0, 0, 0); } } while (0)
#define PG8_WAIT_V(n) asm volatile("s_waitcnt vmcnt(" #n ")" ::: "memory")
#define PG8_WAIT_VL() do { if constexpr (ER) PG8_WAIT_V(9); else PG8_WAIT_V(8); } while (0)
#define PG8_WAIT_L(n) asm volatile("s_waitcnt lgkmcnt(" #n ")" ::: "memory")
#define PG8_BAR __builtin_amdgcn_s_barrier()
#define PG8_SCHED __builtin_amdgcn_sched_barrier(0)
    Unit cur{0, 0}, nxt{0, 0}; int ui = 0;
    if (!S.next(0, cur)) return;
    f32x4 acc[2][2][4][2]; f32x4 accE[2];
    { float z0 = 0.f; asm volatile("" : "+v"(z0));
#pragma unroll
    for (int a = 0; a < 2; ++a)
#pragma unroll
        for (int b = 0; b < 2; ++b)
#pragma unroll
            for (int m = 0; m < 4; ++m)
#pragma unroll
                for (int n = 0; n < 2; ++n) acc[a][b][m][n] = (f32x4){z0, z0, z0, z0};
    accE[0] = (f32x4){z0, z0, z0, z0}; accE[1] = (f32x4){z0, z0, z0, z0}; }
    bf16x8 At[4][2], B0[2][2], B1[2][2], Et[2];
    const char* cA = (const char*)g.A + (size_t)cur.pm * tstepA + (size_t)cur.pn * g.a_pn * 2; const char* cB = (const char*)g.Bt + (size_t)cur.pn * tstepB;
    const char* cE = (const char*)g.AE + (size_t)cur.pm * estep + (size_t)cur.pn * g.a_pn * 2;
    if constexpr (Epi::SSQL) { if (cur.pm < 64) { const char* sp = (const char*)E.ssq_panel(cur.pm);
        glds16(sp, (unsigned)tid * 16u, (unsigned)__builtin_amdgcn_readfirstlane((int)(ldsbase + (unsigned)SSQL_OFF + ldsw)));
        glds16(sp + 8192, (unsigned)tid * 16u, (unsigned)__builtin_amdgcn_readfirstlane((int)(ldsbase + (unsigned)SSQL_OFF + 8192u + ldsw))); } }
    PG8_STAGE(PG8_SB(0, 0), cB, voffB); PG8_STAGE(PG8_SB(0, 1), cB + hstepB, voffB); PG8_STAGE(PG8_SA(0, 0), cA, voffA); PG8_STAGE(PG8_SA(0, 1), cA + hstepA, voffA); PG8_ESTAGE(0, cE);
    if (wr == 1) PG8_BAR;
    if constexpr (ER) PG8_WAIT_V(3); else PG8_WAIT_V(2);
    PG8_BAR;
    PG8_STAGE(PG8_SB(1, 0), cB + kstep, voffB); PG8_STAGE(PG8_SA(1, 0), cA + kstep, voffA); PG8_STAGE(PG8_SB(1, 1), cB + hstepB + kstep, voffB);
    PG8_WAIT_V(6); PG8_BAR;
    const int l1 = lane_id(), fr1 = l1 & 15, fq1 = l1 >> 4;
    const int aoff = lds_byte(wr * 64 + fr1, fq1 * 8), boff = lds_byte(wc * 32 + fr1, fq1 * 8);
    const int eoff = fr1 * 128 + fq1 * 16;
    for (;;) {
        const bool has_next = S.next(ui + 1, nxt);
        const char* nA = has_next ? (const char*)g.A + (size_t)nxt.pm * tstepA + (size_t)nxt.pn * g.a_pn * 2 : cA; const char* nB = has_next ? (const char*)g.Bt + (size_t)nxt.pn * tstepB : cB;
        const char* nE = has_next ? (const char*)g.AE + (size_t)nxt.pm * estep + (size_t)nxt.pn * g.a_pn * 2 : cE;
#pragma nounroll
        for (int t = 0; t < nt; t += 2) {
            int o0 = ER ? wr * HTB : 0; if constexpr (ER) asm volatile("" : "+s"(o0));
            const int boff0 = boff + o0, boff1 = boff0 + (HTB - 2 * o0);
            const bool last = (t == nt - 2);
            const char* a1 = cA + (size_t)(t + 1) * kstep;
            const char* a2 = last ? nA : cA + (size_t)(t + 2) * kstep; const char* b2 = last ? nB : cB + (size_t)(t + 2) * kstep;
            const char* a3 = a2 + kstep; const char* b3 = b2 + kstep;
            const char* e1 = cE + (size_t)(t + 1) * kstep; const char* e2 = last ? nE : cE + (size_t)(t + 2) * kstep;
            PG8_LDB(B0, 0, 0); PG8_LDB(B1, 0, 1); PG8_SCHED; PG8_LDA(At, 0, 0); PG8_STAGE(PG8_SA(1, 1), a1 + hstepA, voffA); PG8_ESTAGE(1, e1);
            PG8_WAIT_VL(); PG8_WAIT_L(0); PG8_BAR; PG8_MMA(0, 0, At, B0); PG8_MMA(0, 1, At, B1); PG8_BAR; PG8_SCHED;
            PG8_LDA(At, 0, 1); PG8_LDE(0); PG8_STAGE(PG8_SB(0, 0), b2, voffB); PG8_STAGE(PG8_SB(0, 1), b2 + hstepB, voffB); PG8_STAGE(PG8_SA(0, 0), a2, voffA);
            PG8_WAIT_VL(); PG8_WAIT_L(0); PG8_BAR; PG8_MMA(1, 0, At, B0); PG8_MMA(1, 1, At, B1); PG8_EMMA(); PG8_BAR; PG8_SCHED;
            PG8_LDB(B0, 1, 0); PG8_LDB(B1, 1, 1); PG8_SCHED; PG8_LDA(At, 1, 0); PG8_STAGE(PG8_SA(0, 1), a2 + hstepA, voffA); PG8_ESTAGE(0, e2);
            PG8_WAIT_VL(); PG8_WAIT_L(0); PG8_BAR; PG8_MMA(0, 0, At, B0); PG8_MMA(0, 1, At, B1); PG8_BAR; PG8_SCHED;
            PG8_LDA(At, 1, 1); PG8_LDE(1); PG8_STAGE(PG8_SB(1, 0), b3, voffB); PG8_STAGE(PG8_SB(1, 1), b3 + hstepB, voffB); PG8_STAGE(PG8_SA(1, 0), a3, voffA);
            PG8_WAIT_VL(); PG8_WAIT_L(0); PG8_BAR; PG8_MMA(1, 0, At, B0); PG8_MMA(1, 1, At, B1); PG8_EMMA(); PG8_BAR; PG8_SCHED;
        }
        if (wr == 0) PG8_BAR;
        { const int l2 = lane_id(); if constexpr (Epi::SSQL) E(acc, accE, cur, wr, wc, l2 & 15, l2 >> 4, has_next ? nxt.pm : -1, ldsbase, wid); else E(acc, accE, cur, wr, wc, l2 & 15, l2 >> 4); }
        if (!has_next) break;
        { float z0 = 0.f; asm volatile("" : "+v"(z0));
#pragma unroll
        for (int a = 0; a < 2; ++a)
#pragma unroll
            for (int b = 0; b < 2; ++b)
#pragma unroll
                for (int m = 0; m < 4; ++m)
#pragma unroll
                    for (int n = 0; n < 2; ++n) acc[a][b][m][n] = (f32x4){z0, z0, z0, z0};
        accE[0] = (f32x4){z0, z0, z0, z0}; accE[1] = (f32x4){z0, z0, z0, z0}; }
        cur = nxt; cA = nA; cB = nB; cE = nE; ++ui;
        if (wr == 1) PG8_BAR;
    }
    PG8_WAIT_V(0);
    PG8_BAR;
#undef PG8_SA
#undef PG8_SB
#undef PG8_STAGE
#undef PG8_ESTAGE
#undef PG8_LDA
#undef PG8_LDB
#undef PG8_LDE
#undef PG8_MMA
#undef PG8_EMMA
#undef PG8_WAIT_V
#undef PG8_WAIT_VL
#undef PG8_WAIT_L
#undef PG8_BAR
#undef PG8_SCHED
}
}
using pg8::Unit;

struct Bases { const float* const* in; float* out; unsigned char* ws; };
template <class P> __device__ __forceinline__ P opaque_uniform(P p) {
    unsigned long long v = (unsigned long long)p; unsigned lo = __builtin_amdgcn_readfirstlane((unsigned)v), hi = __builtin_amdgcn_readfirstlane((unsigned)(v >> 32));
    asm volatile("" : "+s"(lo), "+s"(hi)); return (P)(((unsigned long long)hi << 32) | lo);
}
#define EPI_BASES(B) const float* const* in_ = (B).in; float* out0_ = (B).out; unsigned char* ws0_ = (B).ws; asm volatile("" : "+s"(out0_), "+s"(ws0_)); GAS float* const out_ = (GAS float*)out0_; GAS unsigned char* const ws_ = (GAS unsigned char*)ws0_; (void)in_; (void)out_; (void)ws_
__device__ __forceinline__ void ld_res8(const GAS void* base, bool f32src, size_t eoff, f32x4& a, f32x4& b) {
    if (f32src) { const GAS float* p = (const GAS float*)base + eoff; a = *(const GAS f32x4*)p; b = *(const GAS f32x4*)(p + 4); }
    else { const u32x4 w = *(const GAS u32x4*)((const GAS bf16_t*)base + eoff); a = (f32x4){bf_lo(w.x), bf_hi(w.x), bf_lo(w.y), bf_hi(w.y)}; b = (f32x4){bf_lo(w.z), bf_hi(w.z), bf_lo(w.w), bf_hi(w.w)}; }
}
struct EpiRes {
    static constexpr bool SSQL = false;
    Bases B; int src; int dry;
    template <bool F32, int NB, bool dry>
    __device__ __forceinline__ void run(f32x4 (&acc)[2][2][4][2], f32x4 (&accE)[2], const Unit& u, int wr, int wc, int fr, int fq, const GAS void* rin_p, const GAS void* rin_s, GAS bf16_t* hb, GAS float* ssq, GAS float* ssqE) const {
        const int colb = u.pn * 256 + wc * 32 + 8 * fq;
        const int row0 = u.pm * 256 + wr * 64 + fr;
        const int sr = u.pm * 8 + (fr & 7), colE = colb + wr * 128;
        f32x4 e0, e1; ld_res8(rin_s, F32, (size_t)sr * D + colE, e0, e1);
#pragma unroll
        for (int b0 = 0; b0 < 8; b0 += NB) {
            f32x4 rf[F32 ? NB : 1][4]; u32x4 rb[F32 ? 1 : NB][2];
#pragma unroll
            for (int i = 0; i < NB; ++i) {
                const int g = b0 + i; const size_t ro = (size_t)(row0 + (g >> 2) * 128 + (g & 3) * 16) * D + colb;
#pragma unroll
                for (int bj = 0; bj < 2; ++bj) {
                    if (F32) { const GAS float* p = (const GAS float*)rin_p + ro + (bj ^ wr) * 128; rf[F32 ? i : 0][2 * bj] = *(const GAS f32x4*)p; rf[F32 ? i : 0][2 * bj + 1] = *(const GAS f32x4*)(p + 4); }
                    else rb[F32 ? 0 : i][bj] = *(const GAS u32x4*)((const GAS bf16_t*)rin_p + ro + (bj ^ wr) * 128);
                }
            }
            CFENCE();
#pragma unroll
            for (int i = 0; i < NB; ++i) {
                const int g = b0 + i, ai = g >> 2, m = g & 3;
                const int row = row0 + ai * 128 + m * 16;
                float s = 0.f;
#pragma unroll
                for (int bj = 0; bj < 2; ++bj) {
                    const int col = colb + (bj ^ wr) * 128;
                    f32x4 c0, c1;
                    if (F32) { c0 = rf[F32 ? i : 0][2 * bj]; c1 = rf[F32 ? i : 0][2 * bj + 1]; }
                    else { const u32x4 w = rb[F32 ? 0 : i][bj]; c0 = (f32x4){bf_lo(w.x), bf_hi(w.x), bf_lo(w.y), bf_hi(w.y)}; c1 = (f32x4){bf_lo(w.z), bf_hi(w.z), bf_lo(w.w), bf_hi(w.w)}; }
                    const f32x4 v0 = acc[ai][bj][m][0] + c0, v1 = acc[ai][bj][m][1] + c1;
                    u32x4 w; w.x = pk2(v0.x, v0.y); w.y = pk2(v0.z, v0.w); w.z = pk2(v1.x, v1.y); w.w = pk2(v1.z, v1.w);
                    if (!dry) *(GAS u32x4*)(hb + (size_t)row * D + col) = w;
                    s += (v0.x * v0.x + v0.y * v0.y) + (v0.z * v0.z + v0.w * v0.w) + (v1.x * v1.x + v1.y * v1.y) + (v1.z * v1.z + v1.w * v1.w);
                }
                s = sum_x16(s); s = sum_x32(s);
                if (!dry) ssq[(size_t)row * 16 + u.pn * 4 + wc] = s;
            }
            CFENCE();
        }
        {
            const f32x4 v0 = accE[0] + e0, v1 = accE[1] + e1;
            u32x4 w; w.x = pk2(v0.x, v0.y); w.y = pk2(v0.z, v0.w); w.z = pk2(v1.x, v1.y); w.w = pk2(v1.z, v1.w);
            float q = (v0.x * v0.x + v0.y * v0.y) + (v0.z * v0.z + v0.w * v0.w) + (v1.x * v1.x + v1.y * v1.y) + (v1.z * v1.z + v1.w * v1.w);
            q = sum_x16(q); q = sum_x32(q);
            if (fr < 8 && !dry) {
                *(GAS u32x4*)(hb + (size_t)(TP + sr) * D + colE) = w;
                if (fq == 0) ssqE[(size_t)sr * 32 + (u.pn * 4 + wc) * 2 + wr] = q;
            }
        }
    }
    __device__ __forceinline__ void operator()(f32x4 (&acc)[2][2][4][2], f32x4 (&accE)[2], const Unit& u, int wr, int wc, int fr, int fq) const {
        EPI_BASES(B);
        const bool f32src = (src == 0);
        const GAS void* rin_p = f32src ? (const GAS void*)in_[I_XP] : (const GAS void*)(ws_ + (src == 1 ? WS_HB1 : WS_HB0));
        const GAS void* rin_s = f32src ? (const GAS void*)in_[I_XS] : (const GAS void*)((const GAS bf16_t*)rin_p + (size_t)TP * D);
        GAS bf16_t* hb = (GAS bf16_t*)(ws_ + WS_HB0); GAS float* ssq = (GAS float*)(ws_ + WS_SSQA); GAS float* ssqE = (GAS float*)(ws_ + WS_SSQEA);
        if (dry) { if (f32src) run<true, 2, true>(acc, accE, u, wr, wc, fr, fq, rin_p, rin_s, hb, ssq, ssqE); else run<false, 4, true>(acc, accE, u, wr, wc, fr, fq, rin_p, rin_s, hb, ssq, ssqE); }
        else if (f32src) run<true, 2, false>(acc, accE, u, wr, wc, fr, fq, rin_p, rin_s, hb, ssq, ssqE);
        else run<false, 4, false>(acc, accE, u, wr, wc, fr, fq, rin_p, rin_s, hb, ssq, ssqE);
    }
};
struct EpiBf16 {
    static constexpr bool SSQL = false;
    Bases B; int buf;
    __device__ __forceinline__ void operator()(f32x4 (&acc)[2][2][4][2], f32x4 (&accE)[2], const Unit& u, int wr, int wc, int fr, int fq) const {
        EPI_BASES(B);
        GAS bf16_t* O = (GAS bf16_t*)(ws_ + (buf ? WS_PPJ3 : WS_PPJ)); constexpr int ldc = D;
        const int colb = u.pn * 256 + wc * 32 + 8 * fq;
#pragma unroll
        for (int ai = 0; ai < 2; ++ai)
#pragma unroll
            for (int m = 0; m < 4; ++m) {
                const int row = u.pm * 256 + ai * 128 + wr * 64 + m * 16 + fr;
#pragma unroll
                for (int bj = 0; bj < 2; ++bj) {
                    const f32x4 v0 = acc[ai][bj][m][0], v1 = acc[ai][bj][m][1];
                    u32x4 w; w.x = pk2(v0.x, v0.y); w.y = pk2(v0.z, v0.w); w.z = pk2(v1.x, v1.y); w.w = pk2(v1.z, v1.w);
                    *(GAS u32x4*)(O + (size_t)row * ldc + colb + (bj ^ wr) * 128) = w;
                }
            }
        if (fr < 8) {
            const f32x4 v0 = accE[0], v1 = accE[1];
            u32x4 w; w.x = pk2(v0.x, v0.y); w.y = pk2(v0.z, v0.w); w.z = pk2(v1.x, v1.y); w.w = pk2(v1.z, v1.w);
            *(GAS u32x4*)(O + (size_t)(TP + u.pm * 8 + fr) * ldc + colb + wr * 128) = w;
        }
    }
};
struct EpiPle {
    static constexpr bool SSQL = false;
    Bases B; int write_hb; int last; int dry;
    __device__ __forceinline__ void operator()(f32x4 (&acc)[2][2][4][2], f32x4 (&accE)[2], const Unit& u, int wr, int wc, int fr, int fq) const {
        if (dry) run<false, false, true>(acc, accE, u, wr, wc, fr, fq);
        else if (last) run<true, false, false>(acc, accE, u, wr, wc, fr, fq);
        else if (write_hb) run<false, true, false>(acc, accE, u, wr, wc, fr, fq);
        else run<false, false, false>(acc, accE, u, wr, wc, fr, fq);
    }
    template <bool last, bool write_hb, bool dry>
    __device__ __forceinline__ void run(f32x4 (&acc)[2][2][4][2], f32x4 (&accE)[2], const Unit& u, int wr, int wc, int fr, int fq) const {
        EPI_BASES(B);
        const GAS float* ssq = (const GAS float*)(ws_ + WS_SSQA); const GAS bf16_t* pp = (const GAS bf16_t*)(ws_ + (last ? WS_PPJ3 : WS_PPJ)); const GAS bf16_t* hin = (const GAS bf16_t*)(ws_ + WS_HB0); GAS bf16_t* hb1 = (GAS bf16_t*)(ws_ + WS_HB1); GAS float* y = out_;
        GAS float* ssq_out = (GAS float*)(ws_ + WS_SSQB); const GAS float* ssqE = (const GAS float*)(ws_ + WS_SSQEA); GAS float* ssqE_out = (GAS float*)(ws_ + WS_SSQEB);
        const int colb = u.pn * 256 + wc * 32 + 8 * fq;
        const int row0 = u.pm * 256 + wr * 64 + fr;
#pragma unroll
        for (int b0 = 0; b0 < 8; b0 += 2) {
            f32x4 bsq[2]; u32x4 bh[2][2], bp[2][2];
#pragma unroll
            for (int i = 0; i < 2; ++i) {
                const int g = b0 + i, r1 = row0 + (g >> 2) * 128 + (g & 3) * 16;
                bsq[i] = *(const GAS f32x4*)(ssq + (size_t)r1 * 16 + 4 * fq);
#pragma unroll
                for (int bj = 0; bj < 2; ++bj) { const size_t o = (size_t)r1 * D + colb + (bj ^ wr) * 128; bh[i][bj] = *(const GAS u32x4*)(hin + o); bp[i][bj] = *(const GAS u32x4*)(pp + o); }
            }
            CFENCE();
#pragma unroll
            for (int i = 0; i < 2; ++i) {
                const int g = b0 + i, ai = g >> 2, m = g & 3;
                const int row = row0 + ai * 128 + m * 16;
                const f32x4 csq = bsq[i];
                float rsg; { float q = (csq.x + csq.y) + (csq.z + csq.w); q = sum_x16(q); q = sum_x32(q); rsg = rsq(q * (1.0f / 1024.0f) + EPS); }
                float s = 0.f;
#pragma unroll
                for (int bj = 0; bj < 2; ++bj) {
                    const int col = colb + (bj ^ wr) * 128;
                    const u32x4 pw = bp[i][bj], hw = bh[i][bj];
                    const f32x4 a0 = acc[ai][bj][m][0] * rsg, a1 = acc[ai][bj][m][1] * rsg;
                    f32x4 v0, v1;
                    v0.x = bf_lo(hw.x) + sigmoidf_(a0.x) * bf_lo(pw.x); v0.y = bf_hi(hw.x) + sigmoidf_(a0.y) * bf_hi(pw.x);
                    v0.z = bf_lo(hw.y) + sigmoidf_(a0.z) * bf_lo(pw.y); v0.w = bf_hi(hw.y) + sigmoidf_(a0.w) * bf_hi(pw.y);
                    v1.x = bf_lo(hw.z) + sigmoidf_(a1.x) * bf_lo(pw.z); v1.y = bf_hi(hw.z) + sigmoidf_(a1.y) * bf_hi(pw.z);
                    v1.z = bf_lo(hw.w) + sigmoidf_(a1.z) * bf_lo(pw.w); v1.w = bf_hi(hw.w) + sigmoidf_(a1.w) * bf_hi(pw.w);
                    if (!dry) {
                        if (last) { GAS float* yp = y + (size_t)row * D + col; *(GAS f32x4*)yp = v0; *(GAS f32x4*)(yp + 4) = v1; }
                        else { u32x4 w; w.x = pk2(v0.x, v0.y); w.y = pk2(v0.z, v0.w); w.z = pk2(v1.x, v1.y); w.w = pk2(v1.z, v1.w); *(GAS u32x4*)(hb1 + (size_t)row * D + col) = w; }
                    }
                    if (write_hb) s += (v0.x * v0.x + v0.y * v0.y) + (v0.z * v0.z + v0.w * v0.w) + (v1.x * v1.x + v1.y * v1.y) + (v1.z * v1.z + v1.w * v1.w);
                }
                if (write_hb && !dry) {
                    s = sum_x16(s); s = sum_x32(s);
                    ssq_out[(size_t)row * 16 + u.pn * 4 + wc] = s;
                }
            }
            CFENCE();
        }
        {
            const int sr = u.pm * 8 + (fr & 7), colE = colb + wr * 128;
            const float rse = rstdE(ssqE, sr, fq);
            const size_t o = (size_t)(TP + sr) * D + colE;
            const u32x4 hw = *(const GAS u32x4*)(hin + o), pw = *(const GAS u32x4*)(pp + o);
            const f32x4 a0 = accE[0] * rse, a1 = accE[1] * rse;
            f32x4 v0, v1;
            v0.x = bf_lo(hw.x) + sigmoidf_(a0.x) * bf_lo(pw.x); v0.y = bf_hi(hw.x) + sigmoidf_(a0.y) * bf_hi(pw.x);
            v0.z = bf_lo(hw.y) + sigmoidf_(a0.z) * bf_lo(pw.y); v0.w = bf_hi(hw.y) + sigmoidf_(a0.w) * bf_hi(pw.y);
            v1.x = bf_lo(hw.z) + sigmoidf_(a1.x) * bf_lo(pw.z); v1.y = bf_hi(hw.z) + sigmoidf_(a1.y) * bf_hi(pw.z);
            v1.z = bf_lo(hw.w) + sigmoidf_(a1.z) * bf_lo(pw.w); v1.w = bf_hi(hw.w) + sigmoidf_(a1.w) * bf_hi(pw.w);
            float q = (v0.x * v0.x + v0.y * v0.y) + (v0.z * v0.z + v0.w * v0.w) + (v1.x * v1.x + v1.y * v1.y) + (v1.z * v1.z + v1.w * v1.w);
            q = sum_x16(q); q = sum_x32(q);
            if (fr < 8 && !dry) {
                if (last) { *(GAS f32x4*)(y + o) = v0; *(GAS f32x4*)(y + o + 4) = v1; }
                else { u32x4 w; w.x = pk2(v0.x, v0.y); w.y = pk2(v0.z, v0.w); w.z = pk2(v1.x, v1.y); w.w = pk2(v1.z, v1.w); *(GAS u32x4*)(hb1 + o) = w; }
                if (write_hb && fq == 0) ssqE_out[(size_t)sr * 32 + (u.pn * 4 + wc) * 2 + wr] = q;
            }
        }
    }
};
struct EpiQ {
    static constexpr bool SSQL = false;
    Bases B; int jq; LAS float* XQ;
    __device__ __forceinline__ void operator()(f32x4 (&acc)[2][2][4][2], f32x4 (&accE)[2], const Unit& u, int wr, int wc, int fr, int fq) const {
        EPI_BASES(B);
        const GAS float* ssq = (const GAS float*)(ws_ + WS_SSQB); const GAS float* ssqE = (const GAS float*)(ws_ + WS_SSQEB); const GAS float* qn = (const GAS float*)in_[I_QN] + jq * 64;
        GAS bf16_t* Q = (GAS bf16_t*)(ws_ + WS_DQ);
        const int head = u.pn * 4 + wc;
        f32x4 nv[2][2];
#pragma unroll
        for (int bj = 0; bj < 2; ++bj)
#pragma unroll
            for (int n = 0; n < 2; ++n) nv[bj][n] = *(const GAS f32x4*)(qn + 32 * (bj ^ wr) + 8 * fq + 4 * n) * QSCALE;
        f32x4 nsq = *(const GAS f32x4*)(ssq + (size_t)(u.pm * 256 + wr * 64 + fr) * 16 + 4 * fq);
#pragma unroll
        for (int ai = 0; ai < 2; ++ai)
#pragma unroll
            for (int m = 0; m < 4; ++m) {
                const int row = u.pm * 256 + ai * 128 + wr * 64 + m * 16 + fr;
                const f32x4 csq = nsq;
                if (ai * 4 + m < 7) { const int g1 = ai * 4 + m + 1; nsq = *(const GAS f32x4*)(ssq + (size_t)(u.pm * 256 + (g1 >> 2) * 128 + wr * 64 + (g1 & 3) * 16 + fr) * 16 + 4 * fq); }
                CFENCE();
                float rs; { float q = (csq.x + csq.y) + (csq.z + csq.w); q = sum_x16(q); q = sum_x32(q); rs = rsq(q * (1.0f / 1024.0f) + EPS); }
                f32x4 v[2][2]; float ss = 0.f;
#pragma unroll
                for (int bj = 0; bj < 2; ++bj)
#pragma unroll
                    for (int n = 0; n < 2; ++n) { v[bj][n] = acc[ai][bj][m][n] * rs; const f32x4 x = v[bj][n]; ss += (x.x * x.x + x.y * x.y) + (x.z * x.z + x.w * x.w); }
                ss = sum_x16(ss); ss = sum_x32(ss);
                const float hr = rsq(ss * (1.0f / 64.0f) + EPS);
#pragma unroll
                for (int bj = 0; bj < 2; ++bj) {
                    const f32x4 o0 = v[bj][0] * hr * nv[bj][0], o1 = v[bj][1] * hr * nv[bj][1];
                    u32x4 w; w.x = pk2(o0.x, o0.y); w.y = pk2(o0.z, o0.w); w.z = pk2(o1.x, o1.y); w.w = pk2(o1.z, o1.w);
                    *(GAS u32x4*)(Q + (size_t)row * D + head * 64 + 32 * (bj ^ wr) + 8 * fq) = w;
                }
                CFENCE();
            }
        {
            const int sr = u.pm * 8 + (fr & 7);
            const float rse = rstdE(ssqE, sr, fq);
            const f32x4 v0 = accE[0] * rse, v1 = accE[1] * rse;
            float ss = (v0.x * v0.x + v0.y * v0.y) + (v0.z * v0.z + v0.w * v0.w) + (v1.x * v1.x + v1.y * v1.y) + (v1.z * v1.z + v1.w * v1.w);
            ss = sum_x16(ss); ss = sum_x32(ss);
            if (fq == 0) XQ[(wr * 4 + wc) * 16 + fr] = ss;
            LDS_WAIT(); __builtin_amdgcn_s_barrier(); CFENCE();
            ss += XQ[((1 - wr) * 4 + wc) * 16 + fr];
            const float hr = rsq(ss * (1.0f / 64.0f) + EPS);
            const f32x4 o0 = v0 * hr * nv[0][0], o1 = v1 * hr * nv[0][1];
            u32x4 w; w.x = pk2(o0.x, o0.y); w.y = pk2(o0.z, o0.w); w.z = pk2(o1.x, o1.y); w.w = pk2(o1.z, o1.w);
            if (fr < 8) *(GAS u32x4*)(Q + (size_t)(TP + sr) * D + head * 64 + 32 * wr + 8 * fq) = w;
            __builtin_amdgcn_s_barrier();
        }
    }
};
struct EpiK {
    static constexpr bool SSQL = false;
    Bases B;
    __device__ __forceinline__ void operator()(f32x4 (&acc)[2][2][4][2], f32x4 (&accE)[2], const Unit& u, int wr, int wc, int fr, int fq) const {
        EPI_BASES(B);
        const GAS float* ssq = (const GAS float*)(ws_ + WS_SSQB); const GAS float* ssqE = (const GAS float*)(ws_ + WS_SSQEB); const GAS float* kn = (const GAS float*)in_[I_KN];
        GAS bf16_t* Kb = (GAS bf16_t*)(ws_ + WS_KB); GAS bf16_t* Kext = (GAS bf16_t*)(ws_ + WS_KEXT); GAS float* out = out_;
        const bool sample = u.pm >= 64;
        const int head = wc;
        f32x4 nv[2][2];
#pragma unroll
        for (int bj = 0; bj < 2; ++bj)
#pragma unroll
            for (int n = 0; n < 2; ++n) nv[bj][n] = *(const GAS f32x4*)(kn + 32 * bj + 8 * fq + 4 * n);
        f32x4 sq[8];
#pragma unroll
        for (int g = 0; g < 8; ++g) {
            const int row = u.pm * 256 + (g >> 2) * 128 + wr * 64 + (g & 3) * 16 + fr;
            if (!sample) sq[g] = *(const GAS f32x4*)(ssq + (size_t)row * 16 + 4 * fq);
            else sq[g] = *(const GAS f32x4*)(ssqE + (size_t)(row - TP) * 32 + 8 * fq) + *(const GAS f32x4*)(ssqE + (size_t)(row - TP) * 32 + 8 * fq + 4);
        }
        float rsv[8];
#pragma unroll
        for (int g = 0; g < 8; ++g) { float q = (sq[g].x + sq[g].y) + (sq[g].z + sq[g].w); q = sum_x16(q); q = sum_x32(q); rsv[g] = rsq(q * (1.0f / 1024.0f) + EPS); }
#pragma unroll
        for (int ai = 0; ai < 2; ++ai)
#pragma unroll
            for (int m = 0; m < 4; ++m) {
                const int row = u.pm * 256 + ai * 128 + wr * 64 + m * 16 + fr;
                const float rs = rsv[ai * 4 + m];
                f32x4 v[2][2]; float ss = 0.f;
#pragma unroll
                for (int bj = 0; bj < 2; ++bj)
#pragma unroll
                    for (int n = 0; n < 2; ++n) { v[bj][n] = acc[ai][bj][m][n] * rs; const f32x4 x = v[bj][n]; ss += (x.x * x.x + x.y * x.y) + (x.z * x.z + x.w * x.w); }
                ss = sum_x16(ss); ss = sum_x32(ss);
                const float hr = rsq(ss * (1.0f / 64.0f) + EPS);
#pragma unroll
                for (int bj = 0; bj < 2; ++bj) {
                    const f32x4 o0 = v[bj][0] * hr * nv[bj][0], o1 = v[bj][1] * hr * nv[bj][1];
                    u32x4 w; w.x = pk2(o0.x, o0.y); w.y = pk2(o0.z, o0.w); w.z = pk2(o1.x, o1.y); w.w = pk2(o1.z, o1.w);
                    const int e0 = 32 * bj + 8 * fq;
                    if (!sample) {
                        *(GAS u32x4*)(Kb + kf_off(head, row >> 5, row & 31, e0)) = w;
                        const int t = row & (SEQ - 1);
                        if (t >= SEQ - 128) { GAS float* op = out + OFF_KP + ((size_t)((row >> 13) * 128 + (t - (SEQ - 128)))) * 256 + head * 64 + e0; *(GAS f32x4*)op = o0; *(GAS f32x4*)(op + 4) = o1; }
                    } else {
                        const int s = row - TP, sq = s >> 2, t = s & 3;
                        *(GAS u32x4*)(Kext + kxf_off(sq, head, 4, t, e0)) = w;
                        GAS float* op = out + OFF_KS + ((size_t)(sq * 128 + 124 + t)) * 256 + head * 64 + e0; *(GAS f32x4*)op = o0; *(GAS f32x4*)(op + 4) = o1;
                    }
                }
                CFENCE();
            }
    }
};
struct EpiVt {
    static constexpr bool SSQL = false;
    Bases B;
    __device__ __forceinline__ void operator()(f32x4 (&acc)[2][2][4][2], f32x4 (&accE)[2], const Unit& u, int wr, int wc, int fr, int fq) const {
        EPI_BASES(B);
        const GAS float* ssq = (const GAS float*)(ws_ + WS_SSQB); const GAS float* ssqE = (const GAS float*)(ws_ + WS_SSQEB); GAS bf16_t* Vt = (GAS bf16_t*)(ws_ + WS_VT); GAS bf16_t* Vext = (GAS bf16_t*)(ws_ + WS_VEXT); GAS float* out = out_;
        const int a = fq & 1;
#pragma unroll
        for (int bj = 0; bj < 2; ++bj) {
            const int tk0 = u.pn * 256 + bj * 128 + wc * 32 + 8 * fq;
            float rs[8];
#pragma unroll
            for (int e = 0; e < 8; ++e) {
                float q = (u.pn < 64) ? ssq[(size_t)(tk0 + e) * 16 + fr] : ssqE[(size_t)(tk0 + e - TP) * 32 + fr] + ssqE[(size_t)(tk0 + e - TP) * 32 + 16 + fr];
                q = row16_sum(q);
                rs[e] = rsq(q * (1.0f / 1024.0f) + EPS);
            }
            CFENCE();
#pragma unroll
            for (int ai = 0; ai < 2; ++ai)
#pragma unroll
                for (int m = 0; m < 4; ++m) {
                    const int d = ai * 128 + wr * 64 + m * 16 + fr;
                    f32x4 v0 = acc[ai][bj][m][0], v1 = acc[ai][bj][m][1];
                    v0.x *= rs[0]; v0.y *= rs[1]; v0.z *= rs[2]; v0.w *= rs[3]; v1.x *= rs[4]; v1.y *= rs[5]; v1.z *= rs[6]; v1.w *= rs[7];
                    u32x2 w0, w1; w0.x = pk2(v0.x, v0.y); w0.y = pk2(v0.z, v0.w); w1.x = pk2(v1.x, v1.y); w1.y = pk2(v1.z, v1.w);
                    const int kvh = d >> 6, db = (d >> 5) & 1, dl = d & 31, s2 = (tk0 >> 4) & 1;
                    if (u.pn < 64) {
                        GAS bf16_t* vp = Vt + (size_t)(kvh * NB32 + (tk0 >> 5)) * 2048 + 4 * a;
                        *(GAS u32x2*)(vp + vf_blk(db, s2, 0, dl)) = w0; *(GAS u32x2*)(vp + vf_blk(db, s2, 1, dl)) = w1;
                    }
                    if (u.pn < 64) {
                        if ((u.pn & 31) == 31 && bj == 1) {
                            const int b = u.pn >> 5, w = wc * 32 + 8 * fq;
                            GAS float* op = out + OFF_VP + ((size_t)(b * 128 + w)) * 256 + d;
                            op[0] = v0.x; op[256] = v0.y; op[512] = v0.z; op[768] = v0.w; op[1024] = v1.x; op[1280] = v1.y; op[1536] = v1.z; op[1792] = v1.w;
                        }
                    } else {
                        const int sq = (tk0 - TP) >> 2;
                        *(GAS u32x2*)(Vext + (size_t)((sq * 4 + kvh) * 5 + 4) * 2048 + vf_blk(db, 0, 0, dl)) = w0;
                        *(GAS u32x2*)(Vext + (size_t)(((sq + 1) * 4 + kvh) * 5 + 4) * 2048 + vf_blk(db, 0, 0, dl)) = w1;
                        GAS float* op = out + OFF_VS + ((size_t)(sq * 128 + 124)) * 256 + d;
                        op[0] = v0.x; op[256] = v0.y; op[512] = v0.z; op[768] = v0.w;
                        GAS float* op2 = op + (size_t)128 * 256;
                        op2[0] = v1.x; op2[256] = v1.y; op2[512] = v1.z; op2[768] = v1.w;
                    }
                    CFENCE();
                }
        }
    }
};
template <bool SAMPLE_ONLY, bool ANY>
struct EpiUpT {
    static constexpr bool SSQL = true;
    Bases B; int layer; LAS float* X; int dry;
    __device__ __forceinline__ const float* ssq_panel(int pm) const { return (const float*)(B.ws + WS_SSQA) + (size_t)pm * 256 * 16; }
    __device__ __forceinline__ void operator()(f32x4 (&acc)[2][2][4][2], f32x4 (&accE)[2], const Unit& u, int wr, int wc, int fr, int fq, int next_pm, unsigned ldsbase, int wid) const {
        if (dry == 1) return;
        EPI_BASES(B);
        const GAS float* ssq = (const GAS float*)(ws_ + WS_SSQA); const GAS float* ssqE = (const GAS float*)(ws_ + WS_SSQEA);
        const GAS float* cw = (const GAS float*)in_[I_CONVW] + (size_t)layer * 3 * F2; const GAS float* cb = (const GAS float*)in_[I_CONVB] + (size_t)layer * F2; const GAS float* st_in = (const GAS float*)in_[I_SCONV] + (size_t)layer * NSEQ * 2 * F2;
        GAS bf16_t* act = (GAS bf16_t*)(ws_ + WS_ACT); GAS float* uh = (GAS float*)(ws_ + WS_UH); GAS float* st_p = out_ + OFF_SCP + (size_t)layer * 2 * 2 * F2; GAS float* st_s = out_ + OFF_SCS + (size_t)layer * NSEQ * 2 * F2;
        const bool sample = ANY ? (u.pm >= 64) : SAMPLE_ONLY;
        const int f0 = u.pn * 128 + wc * 32 + 8 * fq;
        const int rbase = u.pm * 256 + wr * 64 + 4 * fr;
        const LAS float* SSQL_ = (const LAS float*)((LAS unsigned char*)X - SCR_OFF + SSQL_OFF);
        f32x4 cwn[4];
        { const int colc0 = f0; cwn[0] = *(const GAS f32x4*)(cw + colc0); cwn[1] = *(const GAS f32x4*)(cw + F2 + colc0); cwn[2] = *(const GAS f32x4*)(cw + 2 * F2 + colc0); cwn[3] = *(const GAS f32x4*)(cb + colc0); }
        {
            f32x4 sq[8];
#pragma unroll
            for (int g = 0; g < 8; ++g) {
                const int row = rbase + (g >> 2) * 128 + (g & 3);
                if (!sample) sq[g] = *(const LAS f32x4*)(SSQL_ + (row - u.pm * 256) * 16 + 4 * fq);
                else sq[g] = *(const GAS f32x4*)(ssqE + (size_t)(row - TP) * 32 + 8 * fq) + *(const GAS f32x4*)(ssqE + (size_t)(row - TP) * 32 + 8 * fq + 4);
            }
#pragma unroll
            for (int g = 0; g < 8; ++g) {
                float q = (sq[g].x + sq[g].y) + (sq[g].z + sq[g].w); q = sum_x16(q); q = sum_x32(q);
                const float rs = rsq(q * (1.0f / 1024.0f) + EPS);
#pragma unroll
                for (int bj = 0; bj < 2; ++bj) { acc[g >> 2][bj][g & 3][0] *= rs; acc[g >> 2][bj][g & 3][1] *= rs; }
            }
            SFENCE();
        }
#define EPIUP_NEXT_SSQ() do { if (next_pm >= 0 && next_pm < 64) { const char* sp = (const char*)ssq_panel(next_pm); const unsigned tid16 = (unsigned)(wid * 64 + lane_id()) * 16u, ldsw = (unsigned)wid * 1024u; \
            glds16(sp, tid16, (unsigned)__builtin_amdgcn_readfirstlane((int)(ldsbase + (unsigned)SSQL_OFF + ldsw))); \
            glds16(sp + 8192, tid16, (unsigned)__builtin_amdgcn_readfirstlane((int)(ldsbase + (unsigned)SSQL_OFF + 8192u + ldsw))); } } while (0)
        if (dry == 2) { LDS_WAIT(); __builtin_amdgcn_s_barrier(); EPIUP_NEXT_SSQ(); return; }
        const int sq0 = (rbase - TP) >> 2;
        if (!sample) {
            if (fr == 15) {
#pragma unroll
                for (int ai = 0; ai < 2; ++ai)
#pragma unroll
                    for (int bj = 0; bj < 2; ++bj)
#pragma unroll
                        for (int k = 0; k < 2; ++k) {
                            LAS float* x = X + ((((wr * 4 + wc) * 2 + ai) * 2 + bj) * 2 + k) * 32 + fq * 8;
                            *(LAS f32x4*)x = acc[ai][bj][2 + k][0]; *(LAS f32x4*)(x + 4) = acc[ai][bj][2 + k][1];
                        }
            }
            if (wr == 0 && fr == 0) {
#pragma unroll
                for (int k = 0; k < 2; ++k)
#pragma unroll
                    for (int bj = 0; bj < 2; ++bj) { GAS float* p = uh + ((size_t)(u.pm * 4 + k)) * F2 + bj * FF + f0; *(GAS f32x4*)p = acc[0][bj][k][0]; *(GAS f32x4*)(p + 4) = acc[0][bj][k][1]; }
            }
            if (wr == 1 && fr == 15) {
#pragma unroll
                for (int k = 0; k < 2; ++k)
#pragma unroll
                    for (int bj = 0; bj < 2; ++bj) { GAS float* p = uh + ((size_t)(u.pm * 4 + 2 + k)) * F2 + bj * FF + f0; *(GAS f32x4*)p = acc[1][bj][2 + k][0]; *(GAS f32x4*)(p + 4) = acc[1][bj][2 + k][1]; }
                if ((u.pm & 31) == 31) {
#pragma unroll
                    for (int k = 0; k < 2; ++k)
#pragma unroll
                        for (int bj = 0; bj < 2; ++bj) { GAS float* p = st_p + ((size_t)((u.pm >> 5) * 2 + k)) * F2 + bj * FF + f0; *(GAS f32x4*)p = acc[1][bj][2 + k][0]; *(GAS f32x4*)(p + 4) = acc[1][bj][2 + k][1]; }
                }
            }
        } else {
#pragma unroll
            for (int ai = 0; ai < 2; ++ai)
#pragma unroll
                for (int k = 0; k < 2; ++k) {
#pragma unroll
                    for (int bj = 0; bj < 2; ++bj) { GAS float* p = st_s + ((size_t)((sq0 + 32 * ai) * 2 + k)) * F2 + bj * FF + f0; *(GAS f32x4*)p = acc[ai][bj][2 + k][0]; *(GAS f32x4*)(p + 4) = acc[ai][bj][2 + k][1]; }
                    CFENCE();
                }
        }
        LDS_WAIT(); __builtin_amdgcn_s_barrier(); SFENCE();
        EPIUP_NEXT_SSQ();
#undef EPIUP_NEXT_SSQ
        if (dry == 3) { __builtin_amdgcn_s_barrier(); return; }
#pragma unroll
        for (int bj = 0; bj < 2; ++bj)
#pragma unroll
            for (int n = 0; n < 2; ++n) {
                const int colc = bj * FF + f0 + 4 * n;
                const f32x4 w0 = cwn[0], w1 = cwn[1], w2 = cwn[2], bb = cwn[3];
                if (bj * 2 + n < 3) {
                    const int sl = bj * 2 + n + 1, cn = (sl >> 1) * FF + f0 + 4 * (sl & 1);
                    cwn[0] = *(const GAS f32x4*)(cw + cn); cwn[1] = *(const GAS f32x4*)(cw + F2 + cn); cwn[2] = *(const GAS f32x4*)(cw + 2 * F2 + cn); cwn[3] = *(const GAS f32x4*)(cb + cn);
                }
                SFENCE();
#pragma unroll
                for (int ai = 0; ai < 2; ++ai) {
                    f32x4 V2 = (f32x4){0.f, 0.f, 0.f, 0.f}, V3 = (f32x4){0.f, 0.f, 0.f, 0.f};
                    if (!sample) {
                        const bool has = !(ai == 0 && wr == 0);
                        const int swr = (ai == 0) ? 0 : (wr == 0 ? 1 : 0), sai = (ai == 1 && wr == 1) ? 1 : 0;
                        const LAS float* x = X + ((((swr * 4 + wc) * 2 + sai) * 2 + bj) * 2) * 32 + fq * 8 + 4 * n;
                        const f32x4 t2 = *(const LAS f32x4*)x, t3 = *(const LAS f32x4*)(x + 32);
                        V2 = has ? t2 : V2; V3 = has ? t3 : V3;
                    } else {
                        const GAS float* sp = st_in + ((size_t)((sq0 + 32 * ai) * 2)) * F2 + colc;
                        V2 = *(const GAS f32x4*)sp; V3 = *(const GAS f32x4*)(sp + F2);
                    }
                    const f32x4 a0 = acc[ai][bj][0][n], a1 = acc[ai][bj][1][n], a2 = acc[ai][bj][2][n], a3 = acc[ai][bj][3][n];
                    f32x4 R2, R3;
                    if (!sample) {
                        R2.x = dpp_old<0x111>(a2.x, V2.x); R2.y = dpp_old<0x111>(a2.y, V2.y); R2.z = dpp_old<0x111>(a2.z, V2.z); R2.w = dpp_old<0x111>(a2.w, V2.w);
                        R3.x = dpp_old<0x111>(a3.x, V3.x); R3.y = dpp_old<0x111>(a3.y, V3.y); R3.z = dpp_old<0x111>(a3.z, V3.z); R3.w = dpp_old<0x111>(a3.w, V3.w);
                    } else { R2 = V2; R3 = V3; }
                    f32x4 c0 = bb + w0 * R2 + w1 * R3 + w2 * a0;
                    f32x4 c1 = bb + w0 * R3 + w1 * a0 + w2 * a1;
                    f32x4 c2 = bb + w0 * a0 + w1 * a1 + w2 * a2;
                    f32x4 c3 = bb + w0 * a1 + w1 * a2 + w2 * a3;
                    if (bj == 0) {
                        c0 = gelu_tanh4(c0); c1 = gelu_tanh4(c1); c2 = gelu_tanh4(c2); c3 = gelu_tanh4(c3);
                    }
                    acc[ai][bj][0][n] = c0; acc[ai][bj][1][n] = c1; acc[ai][bj][2][n] = c2; acc[ai][bj][3][n] = c3;
                    asm volatile("" : "+v"(acc[ai][bj][0][n]), "+v"(acc[ai][bj][1][n]), "+v"(acc[ai][bj][2][n]), "+v"(acc[ai][bj][3][n]));
                }
            }
        if (dry == 4) { __builtin_amdgcn_s_barrier(); return; }
#pragma unroll
        for (int ai = 0; ai < 2; ++ai)
#pragma unroll
            for (int m = 0; m < 4; ++m) {
                const int row = rbase + ai * 128 + m;
                const f32x4 a0 = acc[ai][0][m][0] * acc[ai][1][m][0], a1 = acc[ai][0][m][1] * acc[ai][1][m][1];
                u32x4 w; w.x = pk2(a0.x, a0.y); w.y = pk2(a0.z, a0.w); w.z = pk2(a1.x, a1.y); w.w = pk2(a1.z, a1.w);
                *(GAS u32x4*)(act + (size_t)row * FF + f0) = w;
                SFENCE();
            }
        __builtin_amdgcn_s_barrier();
    }
};

#define XB_TMO      128
#define XB_XCNT(j)  (256  + 64 * (j))
#define XB_XSUB(j)  (1280 + 64 * (j))
#define XB_XGEN(j)  (2304 + 64 * (j))
#define XB_TOP      3328
#define XB_TOPGEN   3392
#define XCD_BAR_WORDS 3456
#define XB_SPIN_CAP (1u << 20)
__device__ __forceinline__ unsigned xb_ld(unsigned* p)              { return __hip_atomic_load(p, __ATOMIC_RELAXED, __HIP_MEMORY_SCOPE_AGENT); }
__device__ __forceinline__ unsigned xb_add(unsigned* p, unsigned v) { return __hip_atomic_fetch_add(p, v, __ATOMIC_RELAXED, __HIP_MEMORY_SCOPE_AGENT); }
__device__ __forceinline__ unsigned xb_xcc_id() { return (unsigned)__builtin_amdgcn_s_getreg((3 << 11) | 20) & 0xFu; }
#define XB_SPIN(cond, bar) do { unsigned _sp = 0; while (cond) { __builtin_amdgcn_s_sleep(1); \
    if ((++_sp & 255u) == 0u) { if (xb_ld(&(bar)[XB_TMO])) break; if (_sp > XB_SPIN_CAP) { atomicAdd(&(bar)[XB_TMO], 1u); break; } } } } while (0)
struct XcdBarrier { unsigned* bar; unsigned x; volatile LAS unsigned* st; };
__device__ __forceinline__ XcdBarrier xcd_barrier_post(unsigned* bar, volatile LAS unsigned* st, int tid) {
    XcdBarrier b; b.bar = bar; b.x = xb_xcc_id(); b.st = st;
    if (tid == 0) (void)xb_add(&bar[XB_XCNT(b.x)], 1u);
    return b;
}
__device__ __forceinline__ void xcd_barrier_complete(unsigned* bar, unsigned x, unsigned& nloc, unsigned& nx) {
    const unsigned G = gridDim.x * gridDim.y * gridDim.z;
    unsigned sum, cnt, mine, sp = 0u;
    for (;;) {
        sum = 0u; cnt = 0u; mine = 0u;
#pragma unroll
        for (unsigned j = 0; j < 16; ++j) { const unsigned c = xb_ld(&bar[XB_XCNT(j)]); sum += c; cnt += (c > 0u) ? 1u : 0u; mine = (j == x) ? c : mine; }
        if (sum == G) break;
        __builtin_amdgcn_s_sleep(1);
        if ((++sp & 255u) == 0u) { if (xb_ld(&bar[XB_TMO])) break; if (sp > XB_SPIN_CAP) { atomicAdd(&bar[XB_TMO], 1u); break; } }
    }
    nloc = mine > 0u ? mine : 1u; nx = cnt > 0u ? cnt : 1u;
}
__device__ __forceinline__ void xcd_barrier(const XcdBarrier& b, int tid) {
    asm volatile("s_waitcnt vmcnt(0)" ::: "memory");
    __syncthreads();
    if (tid == 0) {
        unsigned* bar = b.bar;
        __builtin_amdgcn_s_waitcnt(0);
        unsigned nloc = b.st[0], nx = b.st[1];
        if (nloc == 0u) { xcd_barrier_complete(bar, b.x, nloc, nx); b.st[0] = nloc; b.st[1] = nx; }
        const unsigned old = xb_add(&bar[XB_XSUB(b.x)], 1u);
        const unsigned gen = old / nloc;
        if (old + 1u == (gen + 1u) * nloc) {
            __builtin_amdgcn_fence(__ATOMIC_RELEASE, "agent");
            asm volatile("s_waitcnt vmcnt(0)" ::: "memory");
            const unsigned og = xb_add(&bar[XB_TOP], 1u);
            const unsigned tg = og / nx, target = (tg + 1u) * nx;
            if (og + 1u != target) XB_SPIN((int)(xb_ld(&bar[XB_TOP]) - target) < 0, bar);
            (void)xb_add(&bar[XB_XGEN(b.x)], 1u);
            __builtin_amdgcn_fence(__ATOMIC_ACQUIRE, "agent");
            asm volatile("s_waitcnt vmcnt(0)" ::: "memory");
        } else {
            XB_SPIN(xb_ld(&bar[XB_XGEN(b.x)]) == gen, bar);
            __builtin_amdgcn_fence(__ATOMIC_ACQUIRE, "agent");
            asm volatile("s_waitcnt vmcnt(0)" ::: "memory");
        }
    }
    __syncthreads();
}

constexpr int MAXPROG = 48;
struct Args { const float* in[N_IN]; float* out; unsigned char* ws; int ph_lo, ph_hi, li, pad; unsigned prog[MAXPROG]; };
struct Frame {
    LAS unsigned char* lds; int wave, vcu, G;
    const float* const* in; float* out; unsigned char* ws;
};
template <class X> __device__ __forceinline__ X* wsp(const Frame& F, size_t off) { return (X*)(F.ws + off); }
__device__ __forceinline__ int ftid(const Frame& F) { return F.wave * 64 + lane_id(); }

struct WJob { const float* W; int ldw; bf16_t* WT; int ldt, k0, n0, orow0; const float* ks; const float* ns; };
struct WVals { float v[32]; float nsc; f32x4 k0v, k1v; };
__device__ __forceinline__ void job_load(const WJob& j, int lane, WVals& x) {
    const int nn = lane & 31;
    x.nsc = j.ns ? j.ns[j.n0 + nn] : 1.0f;
    const int c = lane & 7;
    x.k0v = (f32x4){1.f, 1.f, 1.f, 1.f}; x.k1v = (f32x4){1.f, 1.f, 1.f, 1.f};
    if (j.ks) { x.k0v = *(const f32x4*)(j.ks + j.k0 + 8 * c); x.k1v = *(const f32x4*)(j.ks + j.k0 + 8 * c + 4); }
#pragma unroll
    for (int i = 0; i < 32; ++i) x.v[i] = __builtin_nontemporal_load(j.W + (size_t)(j.k0 + 2 * i + (lane >> 5)) * j.ldw + j.n0 + nn);
}
__device__ __forceinline__ void job_finish(const WJob& j, const WVals& x, LAS float* scr, int lane) {
    const int nn = lane & 31;
#pragma unroll
    for (int i = 0; i < 32; ++i) scr[(2 * i + (lane >> 5)) * 33 + nn] = x.v[i] * x.nsc;
    LDS_WAIT(); asm volatile("" ::: "memory");
    const int c = lane & 7;
#pragma unroll
    for (int jj = 0; jj < 4; ++jj) { const int n = (lane >> 3) + 8 * jj; const LAS float* s = scr + (8 * c) * 33 + n;
        u32x4 o; o.x = pk2(s[0 * 33] * x.k0v.x, s[1 * 33] * x.k0v.y); o.y = pk2(s[2 * 33] * x.k0v.z, s[3 * 33] * x.k0v.w); o.z = pk2(s[4 * 33] * x.k1v.x, s[5 * 33] * x.k1v.y); o.w = pk2(s[6 * 33] * x.k1v.z, s[7 * 33] * x.k1v.w);
        *(u32x4*)(j.WT + (size_t)(j.orow0 + n) * j.ldt + j.k0 + 8 * c) = o; }
    LDS_WAIT(); asm volatile("" ::: "memory");
}
__device__ __forceinline__ int map_up(int n0) { return n0 < FF ? 256 * (n0 >> 7) + (n0 & 127) : 256 * ((n0 - FF) >> 7) + 128 + ((n0 - FF) & 127); }
__device__ __forceinline__ int map_head(int n0) { const int head = n0 >> 6, bj = (n0 >> 5) & 1; return 256 * (head >> 2) + 128 * bj + 32 * (head & 3); }
__device__ __forceinline__ WJob make_job(const float* W, int K, int N, bf16_t* WT, int ldt, const float* ks, const float* ns, int maptype, int r) {
    const int nblk = N / 32, kb = r / nblk, nb = r % nblk, n0 = 32 * nb;
    const int orow0 = maptype == 1 ? map_up(n0) : (maptype == 2 ? map_head(n0) : n0);
    return WJob{W, N, WT, ldt, 64 * kb, n0, orow0, ks, ns};
}

template <bool BF> __device__ __forceinline__ f32x2 ld2(const void* src, size_t e) {
    if (BF) { const unsigned w = *(const unsigned*)((const bf16_t*)src + e); return (f32x2){bf_lo(w), bf_hi(w)}; }
    else return *(const f32x2*)((const float*)src + e);
}
template <int W, bool OUT, bool BF>
__device__ __forceinline__ void pool_block16(const void* hsrc, int b, int t0, int blk, const LAS float* rsL, float g0, float g1, int c0, float (&r0)[16], float (&r1)[16], float& S0, float& S1, bf16_t* Dq, float* st_out, const LAS unsigned char* rows) {
    f32x2 v[16];
#pragma unroll
    for (int kk = 0; kk < 16; ++kk) { const int t = t0 + blk * 16 + kk - 16;
        if (OUT) { const unsigned w = *(const LAS unsigned*)(rows + (blk * 16 + kk - 16) * 2048 + 2 * c0); v[kk] = (f32x2){bf_lo(w), bf_hi(w)}; }
        else v[kk] = ld2<BF>(hsrc, ((size_t)(b * SEQ + (t < 0 ? 0 : t))) * D + c0); }
#pragma unroll
    for (int kk = 0; kk < 16; ++kk) {
        const int k = blk * 16 + kk, t = t0 + k - 16;
        const float rs = rsL[k]; const float x0 = v[kk].x * rs * g0, x1 = v[kk].y * rs * g1;
        S0 += x0 - r0[(kk - W) & 15]; r0[kk] = x0; S1 += x1 - r1[(kk - W) & 15]; r1[kk] = x1;
        if (OUT) {
            const int cnt = (t + 1 < W) ? t + 1 : W; const float inv = __builtin_amdgcn_rcpf((float)cnt);
            *(unsigned*)(Dq + ((size_t)(b * SEQ + t)) * D + c0) = pk2(S0 * inv - x0, S1 * inv - x1);
        }
    }
}
template <int W, bool BF>
__device__ __forceinline__ void pool_cols_prompt(const void* hsrc, int b, int t0, const LAS float* rsL, const float* gm, bf16_t* Dq, float* st_out, int tid, const LAS unsigned char* rows) {
    const int c0 = 2 * tid; const float g0 = gm[c0], g1 = gm[c0 + 1];
    float r0[16], r1[16];
#pragma unroll
    for (int k = 0; k < 16; ++k) { r0[k] = 0.f; r1[k] = 0.f; }
    float S0 = 0.f, S1 = 0.f;
    pool_block16<W, false, BF>(hsrc, b, t0, 0, rsL, g0, g1, c0, r0, r1, S0, S1, Dq, st_out, rows);
    for (int blk = 1; blk < 5; ++blk) pool_block16<W, true, BF>(hsrc, b, t0, blk, rsL, g0, g1, c0, r0, r1, S0, S1, Dq, st_out, rows);
}
template <int W, bool BF>
__device__ __forceinline__ void pool_cols_sample(const void* hs, const float* st_in, int sq, const LAS float* rsL, const float* gm, bf16_t* Dq, float* st_out, int tid) {
    const int c0 = 2 * tid; const float g0 = gm[c0], g1 = gm[c0 + 1];
    float r0[16], r1[16]; float S0 = 0.f, S1 = 0.f;
    r0[0] = 0.f; r1[0] = 0.f;
#pragma unroll
    for (int k = 1; k < 16; ++k) { const f32x2 v = *(const f32x2*)(st_in + ((size_t)(sq * 15 + k - 1)) * D + c0); r0[k] = v.x; r1[k] = v.y; }
#pragma unroll
    for (int k = 16 - W; k < 16; ++k) { S0 += r0[k]; S1 += r1[k]; }
#pragma unroll
    for (int k = 5; k < 16; ++k) { f32x2 o = {r0[k], r1[k]}; *(f32x2*)(st_out + ((size_t)(sq * 15 + k - 5)) * D + c0) = o; }
    const float inv = 1.0f / (float)W;
#pragma unroll
    for (int kk = 0; kk < 4; ++kk) {
        const f32x2 v = ld2<BF>(hs, ((size_t)(sq * 4 + kk)) * D + c0); const float rs = rsL[kk];
        const float x0 = v.x * rs * g0, x1 = v.y * rs * g1;
        S0 += x0 - r0[(kk - W) & 15]; r0[kk] = x0; S1 += x1 - r1[(kk - W) & 15]; r1[kk] = x1;
        *(unsigned*)(Dq + ((size_t)(TP + sq * 4 + kk)) * D + c0) = pk2(S0 * inv - x0, S1 * inv - x1);
        f32x2 o = {x0, x1}; *(f32x2*)(st_out + ((size_t)(sq * 15 + 11 + kk)) * D + c0) = o;
    }
}
template <bool BF> __device__ __forceinline__ void row_load16(const void* src, size_t rowoff, int lane, f32x4 (&v)[4]) {
    if (BF) { const u32x4* p = (const u32x4*)((const bf16_t*)src + rowoff) + lane;
#pragma unroll
        for (int j = 0; j < 2; ++j) { const u32x4 w = p[64 * j]; v[2 * j] = (f32x4){bf_lo(w.x), bf_hi(w.x), bf_lo(w.y), bf_hi(w.y)}; v[2 * j + 1] = (f32x4){bf_lo(w.z), bf_hi(w.z), bf_lo(w.w), bf_hi(w.w)}; } }
    else { const f32x4* p = (const f32x4*)((const float*)src + rowoff) + lane;
#pragma unroll
        for (int j = 0; j < 4; ++j) v[j] = p[64 * j]; }
}
__device__ __forceinline__ float ssq16(const f32x4 (&v)[4]) {
    float q = 0.f;
#pragma unroll
    for (int j = 0; j < 4; ++j) q += (v[j].x * v[j].x + v[j].y * v[j].y) + (v[j].z * v[j].z + v[j].w * v[j].w);
    return wave_sum(q);
}
template <bool BF>
__device__ __forceinline__ void poolprep_phase(const Frame& F, int layer, const void* hp, const void* hs) {
    LAS float* rsL = (LAS float*)(F.lds + SCR_OFF);
    const int tid = ftid(F), lane = tid & 63;
    const float* gm = F.in[I_NMIX] + layer * D;
    bf16_t* Dq = wsp<bf16_t>(F, WS_DQ);
    float* stp = F.out + OFF_SPP + (size_t)layer * 2 * 15 * D;
    float* sts = F.out + OFF_SPS + (size_t)layer * NSEQ * 15 * D;
    const float* st_in = F.in[I_SPOOL] + (size_t)layer * NSEQ * 15 * D;
    __syncthreads();
    for (int ci = F.vcu; ci < 256; ci += F.G) {
        const int b = ci >> 7, t0 = (ci & 127) * 64;
        {
#pragma unroll
            for (int half = 0; half < 2; ++half) {
                f32x4 v[5][4];
#pragma unroll
                for (int i = 0; i < 5; ++i) { const int k = F.wave + 8 * (5 * half + i), t = t0 - 16 + k; row_load16<BF>(hp, ((size_t)(b * SEQ + (t < 0 ? 0 : t))) * D, lane, v[i]); }
#pragma unroll
                for (int i = 0; i < 5; ++i) { const int k = F.wave + 8 * (5 * half + i), t = t0 - 16 + k; const float q = ssq16(v[i]);
                    if (lane == 0) rsL[k] = (t >= 0) ? rsq(q * (1.0f / D) + EPS) : 0.f;
                    if (k >= 16) {
                        LAS unsigned char* rr = F.lds + (k - 16) * 2048;
                        if (BF) {
#pragma unroll
                            for (int j = 0; j < 2; ++j) { u32x4 w; w.x = pk2(v[i][2 * j].x, v[i][2 * j].y); w.y = pk2(v[i][2 * j].z, v[i][2 * j].w); w.z = pk2(v[i][2 * j + 1].x, v[i][2 * j + 1].y); w.w = pk2(v[i][2 * j + 1].z, v[i][2 * j + 1].w);
                                *(LAS u32x4*)(rr + (64 * j + lane) * 16) = w; }
                        } else {
#pragma unroll
                            for (int j = 0; j < 4; ++j) { u32x2 w; w.x = pk2(v[i][j].x, v[i][j].y); w.y = pk2(v[i][j].z, v[i][j].w); *(LAS u32x2*)(rr + (64 * j + lane) * 8) = w; }
                        }
                    } }
            }
        }
        __syncthreads();
        const int g = tid >> 7;
        if (g == 0) pool_cols_prompt<2, BF>(hp, b, t0, rsL, gm, Dq, stp, tid, F.lds);
        else if (g == 1) pool_cols_prompt<4, BF>(hp, b, t0, rsL, gm, Dq, stp, tid, F.lds);
        else if (g == 2) pool_cols_prompt<8, BF>(hp, b, t0, rsL, gm, Dq, stp, tid, F.lds);
        else pool_cols_prompt<16, BF>(hp, b, t0, rsL, gm, Dq, stp, tid, F.lds);
        if (t0 + 64 == SEQ) {
            const int c0 = 2 * tid; const float g0 = gm[c0], g1 = gm[c0 + 1];
#pragma unroll
            for (int r = 0; r < 15; ++r) {
                const int t = SEQ - 15 + r; const float rs = rsL[t - t0 + 16];
                const f32x2 xv = ld2<BF>(hp, ((size_t)(b * SEQ + t)) * D + c0);
                f32x2 o = {xv.x * rs * g0, xv.y * rs * g1}; *(f32x2*)(stp + ((size_t)(b * 15 + r)) * D + c0) = o;
            }
        }
        __syncthreads();
    }
    for (int sq = F.vcu; sq < NSEQ; sq += F.G) {
        if (F.wave < 4) { f32x4 v[4]; row_load16<BF>(hs, ((size_t)(sq * 4 + F.wave)) * D, lane, v); const float r = rsq(ssq16(v) * (1.0f / D) + EPS); if (lane == 0) rsL[F.wave] = r; }
        __syncthreads();
        const int g = tid >> 7;
        if (g == 0) pool_cols_sample<2, BF>(hs, st_in, sq, rsL, gm, Dq, sts, tid);
        else if (g == 1) pool_cols_sample<4, BF>(hs, st_in, sq, rsL, gm, Dq, sts, tid);
        else if (g == 2) pool_cols_sample<8, BF>(hs, st_in, sq, rsL, gm, Dq, sts, tid);
        else pool_cols_sample<16, BF>(hs, st_in, sq, rsL, gm, Dq, sts, tid);
        __syncthreads();
    }
}

__device__ __forceinline__ int t5_bucket(int n) {
    if (n < 16) return n;
    int l = 16 + (int)(logf((float)n / 16.0f) / 2.0794415416798357f * 16.0f);
    return l < 31 ? l : 31;
}
__device__ __forceinline__ WJob layer_job(const Frame& F, int l, int it) {
    constexpr int I_UP = 16 * 176, I_DN = 44 * 32, I_G = 16 * 32, I_PJ = 4 * 32, I_Q = 16 * 32, I_KV = 16 * 8, I_O = 16 * 32, I_PL = 4 * 8;
    int r = it;
    if (r < I_UP) return make_job(F.in[I_WUP] + (size_t)l * D * F2, D, F2, wsp<bf16_t>(F, WS_WUP) + (size_t)l * F2 * D, D, F.in[I_NFFN] + l * D, nullptr, 1, r); r -= I_UP;
    if (r < I_DN) return make_job(F.in[I_WDN] + (size_t)l * FF * D, FF, D, wsp<bf16_t>(F, WS_WDN) + (size_t)l * D * FF, FF, nullptr, nullptr, 0, r); r -= I_DN;
    if (r < I_G) return make_job(F.in[I_WG] + (size_t)l * D * D, D, D, wsp<bf16_t>(F, WS_WG) + (size_t)l * D * D, D, F.in[I_NPLE] + l * D, nullptr, 0, r); r -= I_G;
    if (r < I_PJ) return make_job(F.in[I_WPJ] + (size_t)l * PLE * D, PLE, D, wsp<bf16_t>(F, WS_WP) + (size_t)l * D * PLE, PLE, nullptr, nullptr, 0, r); r -= I_PJ;
    if (l < 2) { const int g = r / I_PL, ig = l * 4 + g; r -= g * I_PL;
        return make_job(F.in[I_WPOOL] + (size_t)ig * 65536, 256, 256, wsp<bf16_t>(F, WS_WPOOL) + (size_t)ig * 65536, 256, nullptr, F.in[I_PSCALE] + ig * 256, 0, r); }
    const int j = l - 2;
    if (r < I_Q) return make_job(F.in[I_WQ] + (size_t)j * D * D, D, D, wsp<bf16_t>(F, WS_WQK) + (size_t)(j ? 1280 : 0) * D, D, F.in[I_NMIX] + (2 + j) * D, nullptr, 2, r); r -= I_Q;
    if (r < I_O) return make_job(F.in[I_WO] + (size_t)j * D * D, D, D, wsp<bf16_t>(F, WS_WO) + (size_t)j * D * D, D, nullptr, nullptr, 0, r); r -= I_O;
    if (r < I_KV) return make_job(F.in[I_WK], D, 256, wsp<bf16_t>(F, WS_WQK) + (size_t)1024 * D, D, F.in[I_KVN], nullptr, 2, r); r -= I_KV;
    return make_job(F.in[I_WV], D, 256, wsp<bf16_t>(F, WS_WV), D, F.in[I_KVN], nullptr, 0, r);
}
__device__ __forceinline__ void convert_layer_weights(const Frame& F, int l, int wi, int nw, LAS float* scr, int lane, int lo = 0, int hi = 1024) {
    constexpr int I_UP = 16 * 176, I_DN = 44 * 32, I_G = 16 * 32, I_PJ = 4 * 32, I_Q = 16 * 32, I_KV = 16 * 8, I_O = 16 * 32, I_PL = 4 * 8;
    const int n_common = I_UP + I_DN + I_G + I_PJ;
    const int n_items = n_common + (l < 2 ? 4 * I_PL : I_Q + I_O + (l == 2 ? 2 * I_KV : 0));
    const int it_end = (int)((long long)n_items * hi / 1024);
    int it = (int)((long long)n_items * lo / 1024) + wi; if (it >= it_end) return;
    WJob A = layer_job(F, l, it), B = A; WVals xa, xb;
    job_load(A, lane, xa);
    for (;;) {
        int itn = it + nw; bool hn = itn < it_end;
        if (hn) { B = layer_job(F, l, itn); job_load(B, lane, xb); }
        job_finish(A, xa, scr, lane);
        if (!hn) break;
        it = itn; itn = it + nw; hn = itn < it_end;
        if (hn) { A = layer_job(F, l, itn); job_load(A, lane, xa); }
        job_finish(B, xb, scr, lane);
        if (!hn) break;
        it = itn;
    }
}
__device__ __forceinline__ void convert_wp(const Frame& F, int l, int wi, int nw, LAS float* scr, int lane, int lo = 0, int hi = 1024) {
    for (int it = 128 * lo / 1024 + wi; it < 128 * hi / 1024; it += nw) {
        const WJob j = make_job(F.in[I_WPJ] + (size_t)l * PLE * D, PLE, D, wsp<bf16_t>(F, WS_WP) + (size_t)l * D * PLE, PLE, nullptr, nullptr, 0, it);
        WVals x; job_load(j, lane, x); job_finish(j, x, scr, lane);
    }
}
__device__ __forceinline__ void convert_pb(const Frame& F, int i, int wi, int nw, int lane, int lo = 0, int hi = 1024) {
    bf16_t* pb = wsp<bf16_t>(F, WS_PB) + (size_t)i * T * PLE;
    for (int row = ((T / 8) * lo / 1024 + wi) * 8; row < ((T / 8) * hi / 1024) * 8; row += nw * 8) {
        const float* src = row < TP ? F.in[I_PP] + ((size_t)i * TP + row) * PLE : F.in[I_PS] + ((size_t)i * 512 + (row - TP)) * PLE;
        f32x4 v[8];
#pragma unroll
        for (int k = 0; k < 8; ++k) v[k] = __builtin_nontemporal_load((const f32x4*)(src + (size_t)k * PLE) + lane);
#pragma unroll
        for (int k = 0; k < 8; ++k) { u32x2 o; o.x = pk2(v[k].x, v[k].y); o.y = pk2(v[k].z, v[k].w); *((u32x2*)(pb + (size_t)(row + k) * PLE) + lane) = o; }
    }
}
__device__ __forceinline__ void p0_prologue(const Frame& F, int part) {
    LAS float* scr = (LAS float*)(F.lds + F.wave * 16384);
    const int tid = ftid(F), lane = tid & 63;
    const int gw = F.vcu * NWAVES + F.wave, NGW = F.G * NWAVES;
    if (part == 0 || part == 1) convert_layer_weights(F, 0, gw, NGW, scr, lane);
    if (F.G != 256) for (int l = 1; l < 4; ++l) convert_layer_weights(F, l, gw, NGW, scr, lane);
    if (part == 0 || part == 2) { convert_pb(F, 0, gw, NGW, lane); if (F.G != 256) for (int l = 1; l < 4; ++l) convert_pb(F, l, gw, NGW, lane); }
    if (part == 0 || part == 3) { bf16_t* kx = wsp<bf16_t>(F, WS_KEXT);
      for (int r4 = gw * 4; r4 < NSEQ * 128; r4 += NGW * 4) {
          const int sq = r4 >> 7, key0 = r4 & 127;
          f32x4 kv[4], vv[4];
#pragma unroll
          for (int k = 0; k < 4; ++k) { kv[k] = __builtin_nontemporal_load((const f32x4*)(F.in[I_CK] + (size_t)(r4 + k) * 256) + lane); vv[k] = *((const f32x4*)(F.in[I_CV] + (size_t)(r4 + k) * 256) + lane); }
#pragma unroll
          for (int k = 0; k < 4; ++k) {
              u32x2 o; o.x = pk2(kv[k].x, kv[k].y); o.y = pk2(kv[k].z, kv[k].w);
              { const int key = key0 + k, e = 4 * (lane & 15); *(u32x2*)(kx + kxf_off(sq, lane >> 4, key >> 5, key & 31, e & ~7) + (e & 7)) = o; }
              if (key0 >= 4) {
                  *((f32x4*)(F.out + OFF_KS + ((size_t)(sq * 128 + key0 + k - 4)) * 256) + lane) = kv[k];
                  *((f32x4*)(F.out + OFF_VS + ((size_t)(sq * 128 + key0 + k - 4)) * 256) + lane) = vv[k];
              }
          }
      } }
    if (part == 0 || part == 3) { bf16_t* vx = wsp<bf16_t>(F, WS_VEXT);
      for (int it = gw; it < NSEQ * 9; it += NGW) {
          const int sq = it / 9, g = it % 9;
          if (g < 8) {
              f32x4 v[16];
#pragma unroll
              for (int k = 0; k < 16; ++k) v[k] = *((const f32x4*)(F.in[I_CV] + ((size_t)(sq * 128 + 16 * g + k)) * 256) + lane);
#pragma unroll
              for (int dd = 0; dd < 4; ++dd) {
                  float e[16];
#pragma unroll
                  for (int p = 0; p < 16; ++p) { const int key = 8 * ((p >> 2) & 1) + 4 * (p >> 3) + (p & 3); e[p] = v[key][dd]; }
                  u32x4 o0, o1; o0.x = pk2(e[0], e[1]); o0.y = pk2(e[2], e[3]); o0.z = pk2(e[4], e[5]); o0.w = pk2(e[6], e[7]); o1.x = pk2(e[8], e[9]); o1.y = pk2(e[10], e[11]); o1.z = pk2(e[12], e[13]); o1.w = pk2(e[14], e[15]);
                  const int d = 4 * lane + dd, kvh = d >> 6, db = (d >> 5) & 1, dl = d & 31;
                  bf16_t* dst = vx + (size_t)((sq * 4 + kvh) * 5 + (g >> 1)) * 2048;
                  *(u32x4*)(dst + vf_blk(db, g & 1, 0, dl)) = o0; *(u32x4*)(dst + vf_blk(db, g & 1, 1, dl)) = o1;
              }
          } else {
              const u32x4 z = {0u, 0u, 0u, 0u};
#pragma unroll
              for (int kvh = 0; kvh < 4; ++kvh) { bf16_t* dst = vx + (size_t)((sq * 4 + kvh) * 5 + 4) * 2048;
#pragma unroll
                  for (int i = 0; i < 4; ++i) *((u32x4*)dst + i * 64 + lane) = z; }
          }
      } }
    { float* bt = wsp<float>(F, WS_BTAB);
      for (int i = F.vcu * 512 + tid; i < 16 * 128 + 32; i += F.G * 512) {
          if (i < 2048) { const int h = i >> 7, d = i & 127; bt[i] = F.in[I_RELB][t5_bucket(d) * 16 + h] * LOG2E; }
          else bt[i] = F.in[I_SINK][i - 2048] * LOG2E;
      } }
    if (part == 0 || part == 4) poolprep_phase<false>(F, 0, F.in[I_XP], F.in[I_XS]);
}

__device__ __forceinline__ void conv_patch(const Frame& F, int layer, int pm) {
    const float* uh = wsp<float>(F, WS_UH); bf16_t* act = wsp<bf16_t>(F, WS_ACT);
    const float* cw = F.in[I_CONVW] + (size_t)layer * 3 * F2; const float* cb = F.in[I_CONVB] + (size_t)layer * F2;
    const bool hasprev = (pm & 31) != 0;
    const float* up = uh + (size_t)((hasprev ? pm - 1 : pm) * 4) * F2;
    const float* uc = uh + (size_t)(pm * 4) * F2;
    const float pz = hasprev ? 1.0f : 0.0f;
    const int tid = ftid(F);
    float v[6][2][8];
#pragma unroll
    for (int k = 0; k < 6; ++k) {
        const int f = tid + k * NWAVES * 64; const int fc = f < FF ? f : FF - 1;
#pragma unroll
        for (int part = 0; part < 2; ++part) {
            const int col = part * FF + fc;
            v[k][part][0] = up[2 * F2 + col]; v[k][part][1] = up[3 * F2 + col]; v[k][part][2] = uc[col]; v[k][part][3] = uc[F2 + col];
            v[k][part][4] = cw[col]; v[k][part][5] = cw[F2 + col]; v[k][part][6] = cw[2 * F2 + col]; v[k][part][7] = cb[col];
        }
    }
#pragma unroll
    for (int k = 0; k < 6; ++k) {
        const int f = tid + k * NWAVES * 64;
        float c0[2], c1[2];
#pragma unroll
        for (int part = 0; part < 2; ++part) {
            const float um2 = v[k][part][0] * pz, um1 = v[k][part][1] * pz, u0 = v[k][part][2], u1 = v[k][part][3], w0 = v[k][part][4], w1 = v[k][part][5], w2 = v[k][part][6], b = v[k][part][7];
            c0[part] = b + w0 * um2 + w1 * um1 + w2 * u0; c1[part] = b + w0 * um1 + w1 * u0 + w2 * u1;
        }
        if (f < FF) {
            act[((size_t)(pm * 256)) * FF + f] = (bf16_t)(pk2(gelu_tanh(c0[0]) * c0[1], 0.f) & 0xffffu);
            act[((size_t)(pm * 256 + 1)) * FF + f] = (bf16_t)(pk2(gelu_tanh(c1[0]) * c1[1], 0.f) & 0xffffu);
        }
    }
}

__device__ __forceinline__ int crow(int r, int hi) { return (r & 3) + 8 * (r >> 2) + 4 * hi; }
template <bool SAMPLE, bool LK>
__device__ __forceinline__ void attn_wave(const Frame& F, int unit, int j, const LAS float* btab, int dry, const LAS unsigned char* klds, const LAS unsigned char* vlds) {
    const int lane = lane_id(), ql = lane & 31, hh = lane >> 5;
    const bf16_t* Q = wsp<bf16_t>(F, WS_DQ); bf16_t* O = wsp<bf16_t>(F, WS_DQ);
    int h, kvh, qrow, c0, qe; bool first; const bf16_t* Kbase; const bf16_t* Vbase;
    if (!SAMPLE) {
        const int nb = unit >> 6, rem = unit & 63, sub = rem >> 4; h = rem & 15; kvh = h >> 2;
        qrow = nb * 128 + 32 * sub + ql; c0 = sub; qe = 128 + 32 * sub + ql; first = (nb & 63) == 0;
        Kbase = wsp<bf16_t>(F, WS_KB) + ((ptrdiff_t)(kvh * NB32 + 4 * nb - 4)) * 2048;
        Vbase = wsp<bf16_t>(F, WS_VT) + ((ptrdiff_t)(kvh * NB32 + 4 * nb - 4)) * 2048;
    } else {
        const int sq = unit >> 2; kvh = unit & 3; const int g4 = (ql >> 2) & 3, t = ql & 3; h = kvh * 4 + g4;
        qrow = TP + 4 * sq + t; c0 = 0; qe = 128 + t; first = false;
        Kbase = wsp<bf16_t>(F, WS_KEXT) + (size_t)((sq * 4 + kvh) * 5) * 2048;
        Vbase = wsp<bf16_t>(F, WS_VEXT) + (size_t)((sq * 4 + kvh) * 5) * 2048;
    }
    bf16x8 qf[4];
#pragma unroll
    for (int s = 0; s < 4; ++s) qf[s] = *(const bf16x8*)(Q + (size_t)qrow * D + h * 64 + 16 * s + 8 * hh);
    bf16x8 kf[5][4];
#pragma unroll
    for (int ci = 0; ci < 5; ++ci) {
        const int c = c0 + ci, ca = (first && c < 4) ? c + 4 : c;
#pragma unroll
        for (int s = 0; s < 4; ++s) { if (LK) kf[ci][s] = *(const LAS bf16x8*)(klds + ca * 4096 + ((s * 2 + hh) * 32 + ql) * 16); else kf[ci][s] = *(const bf16x8*)(Kbase + (ptrdiff_t)ca * 2048 + ((s * 2 + hh) * 32 + ql) * 8); }
    }
    const float sink2 = btab[2048 + j * 16 + h];
    f32x16 S[5];
#pragma unroll
    for (int ci = 0; ci < 5; ++ci) {
        f32x16 a;
#pragma unroll
        for (int r = 0; r < 16; ++r) a[r] = 0.f;
#pragma unroll
        for (int s = 0; s < 4; ++s) a = __builtin_amdgcn_mfma_f32_32x32x16_bf16(kf[ci][s], qf[s], a, 0, 0, 0);
        S[ci] = a;
    }
    bf16x8 vf[5][2][2];
#pragma unroll
    for (int ci = 0; ci < 5; ++ci) {
        const int c = c0 + ci, ca = (first && c < 4) ? c + 4 : c;
#pragma unroll
        for (int s2 = 0; s2 < 2; ++s2)
#pragma unroll
            for (int db = 0; db < 2; ++db) { if (LK) vf[ci][s2][db] = *(const LAS bf16x8*)(vlds + ca * 4096 + (((db * 2 + s2) * 2 + hh) * 32 + ql) * 16); else vf[ci][s2][db] = *(const bf16x8*)(Vbase + (ptrdiff_t)ca * 2048 + (((db * 2 + s2) * 2 + hh) * 32 + ql) * 8); }
    }
    float mx = sink2;
#pragma unroll
    for (int ci = 0; ci < 5; ++ci) {
        const int c = c0 + ci;
        const bool skip = first && c < 4;
#pragma unroll
        for (int r = 0; r < 16; ++r) {
            const int key = 32 * c + crow(r, hh), d = qe - key;
            const bool valid = (!skip) && d >= 0 && d < 128;
            const int dd = d < 0 ? 0 : (d > 127 ? 127 : d);
            const float v = (S[ci][r] + btab[h * 128 + dd]) + (valid ? 0.f : -INFINITY);
            S[ci][r] = v; mx = fmaxf(mx, v);
        }
    }
    mx = max_x32(mx);
    float l = 0.f;
#pragma unroll
    for (int ci = 0; ci < 5; ++ci)
#pragma unroll
        for (int r = 0; r < 16; ++r) { const float p = __builtin_amdgcn_exp2f(S[ci][r] - mx); S[ci][r] = p; l += p; }
    l = sum_x32(l);
    const float inv = 1.0f / (l + __builtin_amdgcn_exp2f(sink2 - mx));
    f32x16 o[2];
#pragma unroll
    for (int r = 0; r < 16; ++r) { o[0][r] = 0.f; o[1][r] = 0.f; }
#pragma unroll
    for (int ci = 0; ci < 5; ++ci) {
#pragma unroll
        for (int s2 = 0; s2 < 2; ++s2) {
            u32x4 pw; pw.x = pk2(S[ci][8 * s2 + 0], S[ci][8 * s2 + 1]); pw.y = pk2(S[ci][8 * s2 + 2], S[ci][8 * s2 + 3]); pw.z = pk2(S[ci][8 * s2 + 4], S[ci][8 * s2 + 5]); pw.w = pk2(S[ci][8 * s2 + 6], S[ci][8 * s2 + 7]);
            const bf16x8 pf = __builtin_bit_cast(bf16x8, pw);
#pragma unroll
            for (int db = 0; db < 2; ++db) o[db] = __builtin_amdgcn_mfma_f32_32x32x16_bf16(vf[ci][s2][db], pf, o[db], 0, 0, 0);
        }
    }
    if ((!SAMPLE || ql < 16) && !dry) {
#pragma unroll
        for (int db = 0; db < 2; ++db)
#pragma unroll
            for (int g = 0; g < 4; ++g) {
                u32x2 w; w.x = pk2(o[db][4 * g] * inv, o[db][4 * g + 1] * inv); w.y = pk2(o[db][4 * g + 2] * inv, o[db][4 * g + 3] * inv);
                *(u32x2*)(O + (size_t)qrow * D + h * 64 + 32 * db + 8 * g + 4 * hh) = w;
            }
    }
}
__device__ __forceinline__ void attn_phase(const Frame& F, int j, int dry) {
    LAS float* btab = (LAS float*)(F.lds + SCR_OFF);
    const float* bt = wsp<float>(F, WS_BTAB);
    const int tid = ftid(F);
    for (int i = tid; i < 2048 + 32; i += NWAVES * 64) btab[i] = bt[i];
    __syncthreads();
    const LAS unsigned char* klds = F.lds; const LAS unsigned char* vlds = F.lds + 32768;
    const unsigned ldsb = (unsigned)(uintptr_t)F.lds;
    for (int bu = F.vcu; bu < 128 * 4; bu += F.G) {
        const int nb = bu >> 2, kvh = bu & 3; const bool first = (nb & 63) == 0;
        const char* kg = (const char*)(wsp<bf16_t>(F, WS_KB) + ((ptrdiff_t)(kvh * NB32 + 4 * nb - 4)) * 2048);
        const char* vg = (const char*)(wsp<bf16_t>(F, WS_VT) + ((ptrdiff_t)(kvh * NB32 + 4 * nb - 4)) * 2048);
#pragma unroll
        for (int i = 0; i < 4; ++i) {
            if (!(first && i < 2)) {
                glds16(kg + i * 8192, (unsigned)tid * 16u, (unsigned)__builtin_amdgcn_readfirstlane((int)(ldsb + i * 8192 + F.wave * 1024)));
                glds16(vg + i * 8192, (unsigned)tid * 16u, (unsigned)__builtin_amdgcn_readfirstlane((int)(ldsb + 32768 + i * 8192 + F.wave * 1024)));
            }
        }
        VM_WAIT(); __syncthreads();
#pragma unroll 1
        for (int r = 0; r < 2; ++r) {
            const int sub = F.wave & 3, h = kvh * 4 + (F.wave >> 2) * 2 + r;
            attn_wave<false, true>(F, nb * 64 + sub * 16 + h, j, btab, dry, klds, vlds);
        }
        __syncthreads();
    }
    for (int u = F.wave * F.G + F.vcu; u < NSEQ * 4; u += F.G * NWAVES) attn_wave<true, false>(F, u, j, btab, dry, klds, vlds);
}

#define PHASE_FN __device__ __forceinline__
struct PhaseCtx { const float* const* in; float* out; unsigned char* ws; int wave, vcu, G, bx, layer, kind, dry; };
__device__ __forceinline__ Frame make_frame(const PhaseCtx& c) {
    extern __shared__ __attribute__((aligned(16))) unsigned char lds[];
    Frame F; F.lds = (LAS unsigned char*)lds; F.wave = c.wave; F.vcu = c.vcu; F.G = c.G; F.in = c.in; F.out = c.out; F.ws = c.ws; return F;
}
PHASE_FN void phase_p0(PhaseCtx c) { const Frame F = make_frame(c); p0_prologue(F, c.dry); }
PHASE_FN void phase_pool(PhaseCtx c) { const Frame F = make_frame(c); const bf16_t* hb1 = wsp<bf16_t>(F, WS_HB1); poolprep_phase<true>(F, c.layer, hb1, hb1 + (size_t)TP * D); }
PHASE_FN void phase_res(PhaseCtx c) {
    const Frame F = make_frame(c); const int layer = c.layer, kind = c.kind, bx = c.bx;
    LAS unsigned char* ebuf = F.lds + SCR_OFF + 8192;
    pg8::Gemm g;
    const Bases BS{F.in, F.out, F.ws};
    EpiRes E; E.B = BS; E.src = (kind == 1) ? 2 : ((kind == 0 && layer == 0) ? 0 : 1); E.dry = c.dry;
    if (kind == 0) { bf16_t* dq = wsp<bf16_t>(F, WS_DQ); g = pg8::Gemm{dq, wsp<bf16_t>(F, WS_WPOOL) + (size_t)layer * D * 256, D, 256, 256, 256, dq + (size_t)TP * D}; }
    else if (kind == 1) { bf16_t* act = wsp<bf16_t>(F, WS_ACT); g = pg8::Gemm{act, wsp<bf16_t>(F, WS_WDN) + (size_t)layer * D * FF, FF, FF, FF, 0, act + (size_t)TP * FF};
        { pg8::StaticOrder S; S.init(TP, D, F.G, bx); pg8::Unit u; for (int i = 0; S.next(i, u); ++i) conv_patch(F, layer, u.pm); }
        VM_WAIT(); __syncthreads(); }
    else { bf16_t* dq = wsp<bf16_t>(F, WS_DQ); g = pg8::Gemm{dq, wsp<bf16_t>(F, WS_WO) + (size_t)(layer - 2) * D * D, D, D, D, 0, dq + (size_t)TP * D}; }
    pg8::gemm_phase<EpiRes, true>(F.lds, ebuf, ftid(F), g, TP, D, F.G, bx, E);
}
PHASE_FN void phase_pp(PhaseCtx c, int layer, int G_, int c_, int lim_) {
    const Frame F = make_frame(c);
    LAS unsigned char* ebuf = F.lds + SCR_OFF + 8192;
    const bf16_t* pb = wsp<bf16_t>(F, WS_PB) + (size_t)layer * T * PLE;
    const pg8::Gemm g2{pb, wsp<bf16_t>(F, WS_WP) + (size_t)layer * D * PLE, PLE, PLE, PLE, 0, pb + (size_t)TP * PLE};
    const EpiBf16 E2{Bases{F.in, F.out, F.ws}, layer == 3 ? 1 : 0};
    pg8::gemm_phase<EpiBf16, true>(F.lds, ebuf, ftid(F), g2, TP, D, G_, c_, E2, lim_);
}
PHASE_FN void phase_up(PhaseCtx c) {
    const Frame F = make_frame(c); const int layer = c.layer;
    bf16_t* hb0 = wsp<bf16_t>(F, WS_HB0);
    const pg8::Gemm g{hb0, wsp<bf16_t>(F, WS_WUP) + (size_t)layer * F2 * D, D, D, D, 0, hb0};
    if (F.G == 256) {
        EpiUpT<false, false> E; E.B = Bases{F.in, F.out, F.ws}; E.layer = layer; E.X = (LAS float*)(F.lds + SCR_OFF); E.dry = c.dry;
        pg8::gemm_phase<EpiUpT<false, false>, false, true, 1>(F.lds, F.lds + SCR_OFF + 8192, ftid(F), g, T, F2, F.G, c.bx, E);
        EpiUpT<true, false> Es; Es.B = Bases{F.in, F.out, F.ws}; Es.layer = layer; Es.X = (LAS float*)(F.lds + SCR_OFF); Es.dry = c.dry;
        pg8::gemm_phase<EpiUpT<true, false>, false, true, 2>(F.lds, F.lds + SCR_OFF + 8192, ftid(F), g, T, F2, F.G, c.bx, Es);
    } else {
        EpiUpT<false, true> E; E.B = Bases{F.in, F.out, F.ws}; E.layer = layer; E.X = (LAS float*)(F.lds + SCR_OFF); E.dry = c.dry;
        pg8::gemm_phase<EpiUpT<false, true>, false, true>(F.lds, F.lds + SCR_OFF + 8192, ftid(F), g, T, F2, F.G, c.bx, E);
    }
    const int n6 = (T / 256) * (F2 / 256) - 5 * F.G;
    if (layer < 3 && !c.dry && F.G == 256 && c.bx >= n6) {
        const int lane = lane_id();
        int z_ = 0; asm volatile("" : "+s"(z_));
        Frame F2 = F; F2.in = F.in + z_; F2.ws = F.ws + z_; F2.out = F.out + z_;
        const bool ga = c.bx < 212; const int wi = (ga ? (c.bx - n6) : (c.bx - 212)) * NWAVES + F.wave, nw = (ga ? 40 : 44) * NWAVES, lo = ga ? 0 : 620, hi = ga ? 620 : 1024;
        LAS float* scr = (LAS float*)(F.lds + F.wave * 16384);
        convert_layer_weights(F2, layer + 1 + z_, wi, nw, scr, lane, lo, hi);
        if (layer != 2) convert_pb(F2, layer + 1 + z_, wi, nw, lane, lo, hi);
        if (layer == 1) {
            convert_pb(F2, 3 + z_, wi, nw, lane, lo, hi);
            convert_wp(F2, 3 + z_, wi, nw, scr, lane, lo, hi);
        }
    }
}
PHASE_FN void phase_ple(PhaseCtx c) {
    const Frame F = make_frame(c); const int layer = c.layer;
    bf16_t* hb0 = wsp<bf16_t>(F, WS_HB0);
    const pg8::Gemm g{hb0, wsp<bf16_t>(F, WS_WG) + (size_t)layer * D * D, D, D, D, 0, hb0 + (size_t)TP * D};
    const EpiPle E{Bases{F.in, F.out, F.ws}, (layer == 1 || layer == 2) ? 1 : 0, (layer == 3) ? 1 : 0, c.dry};
    pg8::gemm_phase<EpiPle, true>(F.lds, F.lds + SCR_OFF + 8192, ftid(F), g, TP, D, F.G, c.bx, E);
}
PHASE_FN void phase_q(PhaseCtx c) {
    const Frame F = make_frame(c); const int jq = c.layer - 2;
    bf16_t* hb1 = wsp<bf16_t>(F, WS_HB1);
    const pg8::Gemm g{hb1, wsp<bf16_t>(F, WS_WQK) + (size_t)(jq ? 1280 : 0) * D, D, D, D, 0, hb1 + (size_t)TP * D};
    const EpiQ E{Bases{F.in, F.out, F.ws}, jq, (LAS float*)(F.lds + SCR_OFF + 12288)};
    pg8::gemm_phase<EpiQ, true>(F.lds, F.lds + SCR_OFF + 8192, ftid(F), g, TP, D, F.G, c.bx, E);
}
PHASE_FN void phase_k(PhaseCtx c) {
    const Frame F = make_frame(c);
    bf16_t* hb1 = wsp<bf16_t>(F, WS_HB1);
    const pg8::Gemm g{hb1, wsp<bf16_t>(F, WS_WQK) + (size_t)1024 * D, D, D, D, 0, hb1};
    const EpiK E{Bases{F.in, F.out, F.ws}};
    pg8::gemm_phase<EpiK, false>(F.lds, F.lds + SCR_OFF + 8192, ftid(F), g, T, 256, F.G, c.bx, E);
}
PHASE_FN void phase_vt(PhaseCtx c) {
    const Frame F = make_frame(c);
    bf16_t* hb1 = wsp<bf16_t>(F, WS_HB1);
    const pg8::Gemm g2{wsp<bf16_t>(F, WS_WV), hb1, D, D, D, 0, hb1};
    const EpiVt E2{Bases{F.in, F.out, F.ws}};
    pg8::gemm_phase<EpiVt, false>(F.lds, F.lds + SCR_OFF + 8192, ftid(F), g2, 256, T, F.G, c.bx - 66, E2);
}
PHASE_FN void phase_attn(PhaseCtx c) { const Frame F = make_frame(c); attn_phase(F, c.layer - 2, c.dry); }

__global__ void __launch_bounds__(NWAVES * 64, 2) yoco_fwd(Args args) {
    extern __shared__ __attribute__((aligned(16))) unsigned char lds[];
    LAS unsigned char* ldsp = (LAS unsigned char*)lds;
    const int wave_s = __builtin_amdgcn_readfirstlane((int)threadIdx.x >> 6);
    PhaseCtx c; c.in = args.in; c.out = args.out; c.ws = args.ws; c.wave = wave_s; c.G = gridDim.x; c.bx = (int)blockIdx.x;
    { const int bx = blockIdx.x; c.vcu = (c.G % 8 == 0) ? (bx % 8) * (c.G / 8) + bx / 8 : bx; }
    volatile LAS unsigned* MISC = (volatile LAS unsigned*)(ldsp + MISC_OFF);
    for (int u = wave_s * 64 + lane_id(); u < (SCR_OFF - RING_BYTES) / 4; u += NWAVES * 64) ((LAS unsigned*)(ldsp + RING_BYTES))[u] = 0u;
    __syncthreads();
    unsigned* ctl = (unsigned*)(args.ws + WS_CTL);
    XcdBarrier bar; bar.bar = ctl + CW_BAR; bar.x = 0; bar.st = nullptr;
    const bool use_bar = (args.ph_hi - args.ph_lo) > 1;
    if (use_bar) bar = xcd_barrier_post(ctl + CW_BAR, MISC + 8, wave_s * 64 + lane_id());
    for (int ph = args.ph_lo; ph < args.ph_hi; ++ph) {
        const unsigned pe = (unsigned)__builtin_amdgcn_readfirstlane((int)args.prog[ph]);
        const int type = (int)(pe & 15u);
        c.layer = (int)((pe >> 4) & 15u); c.kind = (int)((pe >> 8) & 15u); c.dry = (int)((pe >> 12) & 7u);
        if (type == 0) phase_p0(c);
        else if (type == 4) phase_pool(c);
        else if (type == 1) phase_res(c);
        else if (type == 2) phase_up(c);
        else if (type == 3) phase_ple(c);
        else if (type == 5) { phase_q(c); if (c.layer == 2) { phase_k(c); phase_vt(c); } }
        else if (type == 6) phase_attn(c);
        { int npp = 0, lay0 = c.layer, g0 = 0, c0 = 0, lim0 = 0x7fffffff, lay1 = 3, g1 = 0, c1 = 0, lim1 = 0;
          constexpr int ONE = 1 << 20;
          if (type == 1 && c.kind == 1 && (c.layer < 2 || c.G != 256)) { npp = 1; g0 = c.G; c0 = c.bx; }
          else if (c.G == 256 && type == 5 && c.layer == 2) { npp = 2; g0 = 120; c0 = c.bx - 136;
                                                               g1 = ONE; c1 = c.bx - 152; lim1 = 104; }
          else if (c.G == 256 && type == 2 && c.layer == 3) { npp = 1; lay0 = 3;
              if (c.bx < 212) { g0 = 40; c0 = c.bx >= 172 ? 104 + (c.bx - 172) : -ONE; lim0 = 224; }
              else { g0 = ONE; c0 = 224 + (c.bx - 212); lim0 = 256; } }
#pragma nounroll
          for (int k = 0; k < npp; ++k) phase_pp(c, k ? lay1 : lay0, k ? g1 : g0, k ? c1 : c0, k ? lim1 : lim0); }
        if (ph + 1 < args.ph_hi) xcd_barrier(bar, wave_s * 64 + lane_id());
    }
}

extern "C" void kernel_launch(void* const* d_in, const int* in_sizes, int n_in, void* d_out, int out_size, void* d_ws, size_t ws_size, hipStream_t stream) {
    static int grid = 0;
    if (grid == 0) {
        if (n_in != N_IN || (size_t)out_size != OUT_TOTAL || ws_size < WS_END) { fprintf(stderr, "kernel_launch: unexpected shapes: n_in %d out %d ws %zu (need %zu); nothing launched\n", n_in, out_size, ws_size, (size_t)WS_END); grid = -1; return; }
        int dev = 0, cus = 0, per_cu = 0;
        if (hipGetDevice(&dev) != hipSuccess || hipDeviceGetAttribute(&cus, hipDeviceAttributeMultiprocessorCount, dev) != hipSuccess) { fprintf(stderr, "kernel_launch: device query failed\n"); grid = -1; return; }
        if (hipFuncSetAttribute((const void*)yoco_fwd, hipFuncAttributeMaxDynamicSharedMemorySize, LDS_BYTES) != hipSuccess) { fprintf(stderr, "kernel_launch: hipFuncSetAttribute failed\n"); grid = -1; return; }
        if (hipOccupancyMaxActiveBlocksPerMultiprocessor(&per_cu, (const void*)yoco_fwd, NWAVES * 64, LDS_BYTES) != hipSuccess || per_cu < 1) fprintf(stderr, "kernel_launch: occupancy query reports %d blocks per CU\n", per_cu);
        (void)hipGetLastError();
        grid = cus;
    }
    if (grid < 0) return;
    if (hipMemsetAsync((char*)d_ws + WS_CTL, 0, CTL_ZERO_BYTES, stream) != hipSuccess) { fprintf(stderr, "kernel_launch: memset failed\n"); return; }
    Args a{};
    for (int i = 0; i < N_IN; ++i) a.in[i] = (const float*)d_in[i];
    a.out = (float*)d_out; a.ws = (unsigned char*)d_ws;
    int np = 0;
    auto add = [&](int type, int layer, int kind) {
#if PROBE_REP_TYPE >= 0
        if (type == PROBE_REP_TYPE) for (int r = 0; r < PROBE_REPS; ++r) a.prog[np++] = (unsigned)(type | layer << 4 | kind << 8 | PROBE_DRY << 12);
#endif
        a.prog[np++] = (unsigned)(type | layer << 4 | kind << 8);
#if PROBE_REP_TYPE == 7
        for (int r = 0; r < PROBE_REPS; ++r) a.prog[np++] = 7u;
#endif
    };
    add(0, 0, 0);
    for (int l = 0; l < 4; ++l) {
        if (l == 1) add(4, 1, 0);
        if (l < 2) add(1, l, 0); else { add(5, l, 0); add(6, l, 0); add(1, l, 2); }
        add(2, l, 0); add(1, l, 1); add(3, l, 0);
    }
#if MK_N_LAUNCHES == 1
    a.ph_lo = 0; a.ph_hi = np; a.li = 0;
    hipLaunchKernelGGL(yoco_fwd, dim3(grid), dim3(NWAVES * 64), LDS_BYTES, stream, a);
#else
    for (int p = 0; p < np; ++p) { a.ph_lo = p; a.ph_hi = p + 1; a.li = p; hipLaunchKernelGGL(yoco_fwd, dim3(grid), dim3(NWAVES * 64), LDS_BYTES, stream, a); }
#endif
    const hipError_t le = hipPeekAtLastError();
    if (le != hipSuccess) fprintf(stderr, "kernel_launch: launch failed: %s\n", hipGetErrorName(le));
}
```
